# Optimizing an MI355X kernel written in HIP

```python
import math
import jax, jax.numpy as jnp
from jax import lax
import numpy as np

D_MODEL = 1024
BATCH = 8
SEQ = 2048
DEPTH = 2
DEC_BATCH = 128
DEC_SEQ = 8
PAST_LEN = 16384
PAGE_SIZE = 128

N_MIXERS = 2
N_LAYERS_A = (DEPTH + N_MIXERS - 1) // N_MIXERS
N_LAYERS_B = DEPTH // N_MIXERS

A_HEADS = 8
A_DK = 128
A_DV = 128
A_QK = A_HEADS * A_DK
A_VW = A_HEADS * A_DV
A_CONV_CH = 2 * A_QK + A_VW
CONV_W = 4
A_PROJ = A_CONV_CH + A_VW + 2 * A_HEADS

B_HEADS = 4
B_DK = 256
B_DV = 512
B_QK = B_HEADS * B_DK
B_VW = B_HEADS * B_DV
B_PROJ = 2 * B_QK + 2 * B_VW

CHUNK = 64
ROPE_BASE = 10000.0
EPS = 1e-6
F32 = jnp.float32

kernel_name = 'hybrid_gdn_retention_step'


def _rmsnorm(x, w):
    xf = x.astype(F32)
    return xf * lax.rsqrt(jnp.mean(xf * xf, -1, keepdims=True) + EPS) * w.astype(F32)


def _l2norm(x):
    return x * lax.rsqrt(jnp.sum(x * x, -1, keepdims=True) + EPS)


def _chunk_size(L):
    return L if L <= CHUNK else math.gcd(L, CHUNK)


def _to_chunks(t, C):
    B, L = t.shape[:2]
    t = t.reshape((B, L // C, C) + t.shape[2:])
    return jnp.swapaxes(jnp.moveaxis(t, 1, 0), 2, 3)


def _from_chunks(o):
    n, B, H, C, d = o.shape
    return jnp.transpose(o, (1, 0, 3, 2, 4)).reshape(B, n * C, H, d)


def _short_conv(x, buf, w):
    L = x.shape[1]
    xe = jnp.concatenate([buf.astype(F32), x], axis=1)
    out = sum(xe[:, j:j + L] * w[j] for j in range(CONV_W))
    return jax.nn.silu(out), xe[:, L:]


def _gated_delta_chunked(q, k, v, beta, g, S0):
    L = q.shape[1]
    C = _chunk_size(L)
    dv = v.shape[-1]
    idx = jnp.arange(C)
    strict = idx[:, None] > idx[None, :]
    incl = idx[:, None] >= idx[None, :]
    eye = jnp.eye(C, dtype=F32)

    def step(S, inp):
        qc, kc, vc, bc, gc = inp
        G = jnp.cumsum(gc, axis=-1)
        diff = G[..., :, None] - G[..., None, :]
        dec = jnp.where(incl, jnp.exp(jnp.where(incl, diff, 0.0)), 0.0)
        kk = jnp.einsum('bhid,bhjd->bhij', kc, kc)
        low = jnp.where(strict, bc[..., :, None] * kk * dec, 0.0)
        eG = jnp.exp(G)
        rhs = jnp.concatenate([bc[..., None] * vc, (bc * eG)[..., None] * kc], axis=-1)
        sol = lax.linalg.triangular_solve(low + eye, rhs, left_side=True, lower=True,
                                          unit_diagonal=True)
        u = sol[..., :dv] - jnp.einsum('bhck,bhkv->bhcv', sol[..., dv:], S)
        qk = jnp.einsum('bhid,bhjd->bhij', qc, kc) * dec
        o = eG[..., None] * jnp.einsum('bhck,bhkv->bhcv', qc, S) + jnp.einsum('bhij,bhjv->bhiv', qk, u)
        S_new = (jnp.exp(G[..., -1])[..., None, None] * S
                 + jnp.einsum('bhck,bhcv->bhkv', kc * jnp.exp(G[..., -1:] - G)[..., None], u))
        return S_new, o

    xs = tuple(_to_chunks(t.astype(F32), C) for t in (q, k, v, beta, g))
    S, o = lax.scan(step, S0.astype(F32), xs)
    return _from_chunks(o), S


def _retention_chunked(q, k, v, S0):
    L = q.shape[1]
    C = _chunk_size(L)
    lg = jnp.log(1.0 - 2.0 ** (-5.0 - jnp.arange(B_HEADS, dtype=F32)))
    idx = jnp.arange(C, dtype=F32)
    diff = idx[:, None] - idx[None, :]
    D = jnp.where(diff >= 0, jnp.exp(lg[:, None, None] * jnp.maximum(diff, 0.0)), 0.0)
    q_dec = jnp.exp(lg[:, None] * (idx + 1.0))
    k_dec = jnp.exp(lg[:, None] * (C - 1.0 - idx))
    s_dec = jnp.exp(lg * C)

    def step(S, inp):
        qc, kc, vc = inp
        qk = jnp.einsum('bhid,bhjd->bhij', qc, kc) * D
        o = (jnp.einsum('bhij,bhjv->bhiv', qk, vc)
             + q_dec[..., None] * jnp.einsum('bhck,bhkv->bhcv', qc, S))
        S_new = s_dec[:, None, None] * S + jnp.einsum('bhck,bhcv->bhkv', kc * k_dec[..., None], vc)
        return S_new, o

    xs = tuple(_to_chunks(t.astype(F32), C) for t in (q, k, v))
    S, o = lax.scan(step, S0.astype(F32), xs)
    return _from_chunks(o), S


def _rotary(x, pos0):
    L, d = x.shape[1], x.shape[-1]
    half = d // 2
    inv = 1.0 / (ROPE_BASE ** jnp.linspace(0.0, 1.0, half, dtype=F32))
    pos = pos0 + jnp.arange(L, dtype=F32)
    ang = pos[:, None] * inv[None, :]
    cos = jnp.cos(ang)[None, :, None, :]
    sin = jnp.sin(ang)[None, :, None, :]
    x1, x2 = x[..., :half], x[..., half:]
    return jnp.concatenate([x1 * cos - x2 * sin, x1 * sin + x2 * cos], axis=-1)


def _gdn_layer(x, S0, buf, norm_w, w_in, conv_w, a_log, dt_bias, onorm_w, w_out):
    B, L, _ = x.shape
    p = _rmsnorm(x, norm_w) @ w_in.astype(F32)
    mixed, z, b_raw, a_raw = jnp.split(
        p, [A_CONV_CH, A_CONV_CH + A_VW, A_CONV_CH + A_VW + A_HEADS], axis=-1)
    mixed, new_buf = _short_conv(mixed, buf, conv_w.astype(F32))
    q, k, v = jnp.split(mixed, [A_QK, 2 * A_QK], axis=-1)
    q = _l2norm(q.reshape(B, L, A_HEADS, A_DK)) * (A_DK ** -0.5)
    k = _l2norm(k.reshape(B, L, A_HEADS, A_DK))
    v = v.reshape(B, L, A_HEADS, A_DV)
    beta = jax.nn.sigmoid(b_raw)
    g = -jnp.exp(a_log.astype(F32)) * jax.nn.softplus(a_raw + dt_bias.astype(F32))
    o, S = _gated_delta_chunked(q, k, v, beta, g, S0)
    o = _rmsnorm(o, onorm_w) * jax.nn.silu(z.reshape(B, L, A_HEADS, A_DV))
    y = x + (o.reshape(B, L, A_VW) @ w_out.astype(F32)).astype(x.dtype)
    return y, S.astype(x.dtype), new_buf.astype(x.dtype)


def _ret_layer(x, pos0, S0, norm_w, w_in, onorm_w, w_out):
    B, L, _ = x.shape
    p = _rmsnorm(x, norm_w) @ w_in.astype(F32)
    q, k, v, gate = jnp.split(p, [B_QK, 2 * B_QK, 2 * B_QK + B_VW], axis=-1)
    q = _rotary(q.reshape(B, L, B_HEADS, B_DK), pos0)
    k = _rotary(k.reshape(B, L, B_HEADS, B_DK), pos0) * (B_DK ** -0.5)
    v = v.reshape(B, L, B_HEADS, B_DV)
    o, S = _retention_chunked(q, k, v, S0)
    o = _rmsnorm(o, onorm_w) * jax.nn.silu(gate.reshape(B, L, B_HEADS, B_DV))
    y = x + (o.reshape(B, L, B_VW) @ w_out.astype(F32)).astype(x.dtype)
    return y, S.astype(x.dtype)


def _trunk(x, pos0, gdn_S, gdn_conv, ret_S, norm_w, w_in_a, conv_w_a, a_log_a, dt_bias_a,
           onorm_a, w_out_a, w_in_b, onorm_b, w_out_b, final_norm_w):
    sa, ca, sb = [], [], []
    for i in range(DEPTH):
        j = i // N_MIXERS
        if i % N_MIXERS == 0:
            x, s, c = _gdn_layer(x, gdn_S[j], gdn_conv[j], norm_w[i], w_in_a[j], conv_w_a[j],
                                 a_log_a[j], dt_bias_a[j], onorm_a[j], w_out_a[j])
            sa.append(s)
            ca.append(c)
        else:
            x, s = _ret_layer(x, pos0, ret_S[j], norm_w[i], w_in_b[j], onorm_b[j], w_out_b[j])
            sb.append(s)
    y = _rmsnorm(x, final_norm_w).astype(x.dtype)
    return y, jnp.stack(sa), jnp.stack(ca), jnp.stack(sb)


def setup_inputs(seed: int = 0) -> dict:
    key = jax.random.key(seed)
    ks = jax.random.split(key, 16)
    nrm = jax.random.normal
    dt = jnp.exp(jax.random.uniform(ks[8], (N_LAYERS_A, A_HEADS), F32,
                                    math.log(1e-3), math.log(1e-1)))
    return {
        'x_prompt': nrm(ks[0], (BATCH, SEQ, D_MODEL), F32),
        'x_sample': nrm(ks[1], (DEC_BATCH, DEC_SEQ, D_MODEL), F32),
        'state_gdn_ssm': 0.1 * nrm(ks[2], (N_LAYERS_A, DEC_BATCH, A_HEADS, A_DK, A_DV), F32),
        'state_gdn_conv': nrm(ks[3], (N_LAYERS_A, DEC_BATCH, CONV_W - 1, A_CONV_CH), F32),
        'state_ret': 0.1 * nrm(ks[4], (N_LAYERS_B, DEC_BATCH, B_HEADS, B_DK, B_DV), F32),
        'norm_w': 1.0 + 0.02 * nrm(ks[5], (DEPTH, D_MODEL), F32),
        'w_in_a': nrm(ks[6], (N_LAYERS_A, D_MODEL, A_PROJ), F32) * D_MODEL ** -0.5,
        'conv_w_a': nrm(ks[7], (N_LAYERS_A, CONV_W, A_CONV_CH), F32) * CONV_W ** -0.5,
        'a_log_a': jnp.log(jax.random.uniform(ks[9], (N_LAYERS_A, A_HEADS), F32, 1.0, 16.0)),
        'dt_bias_a': dt + jnp.log(-jnp.expm1(-dt)),
        'onorm_a': 1.0 + 0.02 * nrm(ks[10], (N_LAYERS_A, A_DV), F32),
        'w_out_a': nrm(ks[11], (N_LAYERS_A, A_VW, D_MODEL), F32) * A_VW ** -0.5,
        'w_in_b': nrm(ks[12], (N_LAYERS_B, D_MODEL, B_PROJ), F32) * D_MODEL ** -0.5,
        'onorm_b': 1.0 + 0.02 * nrm(ks[13], (N_LAYERS_B, B_HEADS, B_DV), F32),
        'w_out_b': nrm(ks[14], (N_LAYERS_B, B_VW, D_MODEL), F32) * B_VW ** -0.5,
        'final_norm_w': 1.0 + 0.02 * nrm(ks[15], (D_MODEL,), F32),
    }


def reference(x_prompt, x_sample, state_gdn_ssm, state_gdn_conv, state_ret, norm_w, w_in_a,
              conv_w_a, a_log_a, dt_bias_a, onorm_a, w_out_a, w_in_b, onorm_b, w_out_b,
              final_norm_w):
    bp = x_prompt.shape[0]
    dtp = x_prompt.dtype
    z_sa = jnp.zeros((N_LAYERS_A, bp, A_HEADS, A_DK, A_DV), dtp)
    z_ca = jnp.zeros((N_LAYERS_A, bp, CONV_W - 1, A_CONV_CH), dtp)
    z_sb = jnp.zeros((N_LAYERS_B, bp, B_HEADS, B_DK, B_DV), dtp)
    y_prompt, sa_p, ca_p, sb_p = _trunk(x_prompt, 0.0, z_sa, z_ca, z_sb, norm_w, w_in_a,
                                        conv_w_a, a_log_a, dt_bias_a, onorm_a, w_out_a,
                                        w_in_b, onorm_b, w_out_b, final_norm_w)
    y_sample, sa_s, ca_s, sb_s = _trunk(x_sample, float(PAST_LEN), state_gdn_ssm, state_gdn_conv,
                                        state_ret, norm_w, w_in_a, conv_w_a, a_log_a,
                                        dt_bias_a, onorm_a, w_out_a, w_in_b, onorm_b,
                                        w_out_b, final_norm_w)
    return (y_prompt, y_sample, sa_p, ca_p, sb_p, sa_s, ca_s, sb_s)
```

```cpp
#include <hip/hip_runtime.h>
#include <hip/hip_cooperative_groups.h>
#include <cstdio>
namespace cg = cooperative_groups;

#define DI __device__ __forceinline__
#define LAS __attribute__((address_space(3)))
typedef unsigned short bf16_t;
typedef short bf16x8 __attribute__((ext_vector_type(8)));
typedef float f32x2 __attribute__((ext_vector_type(2)));
typedef float f32x4 __attribute__((ext_vector_type(4)));
typedef float f32x16 __attribute__((ext_vector_type(16)));
typedef unsigned u32x2 __attribute__((ext_vector_type(2)));
typedef unsigned u32x4 __attribute__((ext_vector_type(4)));
typedef __bf16 bf2_t __attribute__((ext_vector_type(2)));

constexpr int T_TOK = 17408, T_PR = 16384, DM = 1024;
constexpr int LDP0 = 4352, LDP1 = 6144;
constexpr int NPH = 13;
#ifndef PROBE_MASK
#define PROBE_MASK 0
#endif
constexpr size_t SMEM_BYTES = 153600;

constexpr size_t WS_WTA = 0;
constexpr size_t WS_WTOA = WS_WTA + (size_t)4352 * 1024 * 2;
constexpr size_t WS_WTB = WS_WTOA + (size_t)1024 * 1024 * 2;
constexpr size_t WS_WTOB = WS_WTB + (size_t)6144 * 1024 * 2;
constexpr size_t WS_XN = WS_WTOB + (size_t)1024 * 2048 * 2;
constexpr size_t WS_ORAW = WS_XN + (size_t)T_TOK * 1024 * 2;
constexpr size_t WS_OG = WS_ORAW + (size_t)T_TOK * 2048 * 2;
constexpr size_t WS_X1 = WS_OG + (size_t)T_TOK * 2048 * 2;
constexpr size_t WS_X2 = WS_X1 + (size_t)T_TOK * 1024 * 4;
constexpr size_t ROP_STRIDE = 139264;
constexpr size_t WS_ROP = WS_X2 + (size_t)T_TOK * 1024 * 4;
constexpr size_t WS_RA = WS_ROP + ROP_STRIDE * 1024;
constexpr size_t WS_P0 = WS_RA;
constexpr size_t GOP_STRIDE = 73984;
constexpr size_t WS_GOP = WS_P0 + (size_t)T_TOK * LDP0 * 2;
constexpr size_t WS_PART1 = WS_GOP;
constexpr size_t WS_PART2 = WS_ROP;
constexpr size_t WS_P1 = WS_RA;
constexpr size_t WS_END = WS_GOP + GOP_STRIDE * 2048;
static_assert((size_t)T_TOK * LDP1 * 2 <= WS_END - WS_RA, "P1 alias");
constexpr size_t WS_TABR = WS_END;
constexpr size_t WS_TABC = WS_TABR + 65536;
constexpr size_t WS_TABS = WS_TABC + 32768;
constexpr size_t WS_BAR = WS_TABS + 8192;
constexpr size_t WS_TOTAL = WS_BAR + 16384;
constexpr size_t SMEM_XB = 147456;

constexpr size_t O_Y = 0, O_GSP = 17825792, O_GCP = 18874368, O_RP = 18948096, O_GSS = 23142400, O_GCS = 39919616, O_RS = 41099264;

struct Params {
    const float *xp, *xs, *st_gdn, *st_conv, *st_ret, *norm_w, *w_in_a, *conv_w, *a_log, *dt_bias, *onorm_a, *w_out_a, *w_in_b, *onorm_b, *w_out_b, *fnorm_w;
    float* out;
    unsigned char* ws;
    int ph_lo, ph_hi;
    int use_cg, pad0;
};

DI unsigned pk_bf16(float a, float b) { f32x2 v = {a, b}; bf2_t r = __builtin_convertvector(v, bf2_t); return __builtin_bit_cast(unsigned, r); }
DI bf16_t f2bf(float a) { return (bf16_t)(pk_bf16(a, 0.f) & 0xffffu); }
DI float bf2f(bf16_t b) { return __uint_as_float(((unsigned)b) << 16); }
DI float bflo(unsigned u) { return __uint_as_float(u << 16); }
DI float bfhi(unsigned u) { return __uint_as_float(u & 0xffff0000u); }
DI float silu_f(float x) { return x * __builtin_amdgcn_rcpf(1.f + __expf(-x)); }
DI float row16_sum(float v) {
    v += __builtin_bit_cast(float, __builtin_amdgcn_update_dpp(0, __builtin_bit_cast(int, v), 0xB1, 0xF, 0xF, true));
    v += __builtin_bit_cast(float, __builtin_amdgcn_update_dpp(0, __builtin_bit_cast(int, v), 0x4E, 0xF, 0xF, true));
    v += __builtin_bit_cast(float, __builtin_amdgcn_update_dpp(0, __builtin_bit_cast(int, v), 0x124, 0xF, 0xF, true));
    v += __builtin_bit_cast(float, __builtin_amdgcn_update_dpp(0, __builtin_bit_cast(int, v), 0x128, 0xF, 0xF, true));
    return v;
}
DI float wave_sum(float v) {
    v = row16_sum(v);
    v += __shfl_xor(v, 16);
    v += __shfl_xor(v, 32);
    return v;
}
DI bf16x8 packB(const f32x16& x, const int s) {
    u32x4 p; p.x = pk_bf16(x[8 * s], x[8 * s + 1]); p.y = pk_bf16(x[8 * s + 2], x[8 * s + 3]); p.z = pk_bf16(x[8 * s + 4], x[8 * s + 5]); p.w = pk_bf16(x[8 * s + 6], x[8 * s + 7]);
    return __builtin_bit_cast(bf16x8, p);
}
DI bf16x8 ldA_perm(const bf16_t* rowp, int hh) {
    const u32x2 lo = *(const u32x2*)(rowp + 4 * hh), hi = *(const u32x2*)(rowp + 8 + 4 * hh);
    u32x4 v = {lo.x, lo.y, hi.x, hi.y}; return __builtin_bit_cast(bf16x8, v);
}
DI bf16x8 ld16(const bf16_t* p) { return __builtin_bit_cast(bf16x8, *(const u32x4*)p); }
#define MFMA32(a, b, c) __builtin_amdgcn_mfma_f32_32x32x16_bf16((a), (b), (c), 0, 0, 0)
DI int crow(int i, int hh) { return (i & 3) + 8 * (i >> 2) + 4 * hh; }
DI void lds_barrier() { asm volatile("s_waitcnt lgkmcnt(0)" ::: "memory"); __builtin_amdgcn_s_barrier(); asm volatile("" ::: "memory"); }
DI int opaque_tid() { int t = threadIdx.x; asm volatile("" : "+v"(t)); return t; }


#define XB_TMO      128
#define XB_XCNT(j)  (256  + 64 * (j))
#define XB_XSUB(j)  (1280 + 64 * (j))
#define XB_XGEN(j)  (2304 + 64 * (j))
#define XB_TOP      3328
#define XB_TOPGEN   3392
#define XCD_BAR_WORDS 3456
#define XB_SPIN_CAP (1u << 18)
DI unsigned xb_ld(unsigned* p) { return __hip_atomic_load(p, __ATOMIC_RELAXED, __HIP_MEMORY_SCOPE_AGENT); }
DI unsigned xb_add(unsigned* p, unsigned v) { return __hip_atomic_fetch_add(p, v, __ATOMIC_RELAXED, __HIP_MEMORY_SCOPE_AGENT); }
DI unsigned xb_xcc_id() { return (unsigned)__builtin_amdgcn_s_getreg((3 << 11) | 20) & 0xFu; }
#define XB_SPIN(cond, bar) do { unsigned _sp = 0; while (cond) { __builtin_amdgcn_s_sleep(1); \
    if ((++_sp & 255u) == 0u) { if (xb_ld(&(bar)[XB_TMO])) break; if (_sp > XB_SPIN_CAP) { atomicAdd(&(bar)[XB_TMO], 1u); break; } } } } while (0)
struct XcdBarrier { unsigned* bar; unsigned x; volatile LAS unsigned* st; };
DI XcdBarrier xcd_barrier_post(unsigned* bar, volatile LAS unsigned* st) {
    XcdBarrier b; b.bar = bar; b.x = xb_xcc_id(); b.st = st;
    if (threadIdx.x == 0) (void)xb_add(&bar[XB_XCNT(b.x)], 1u);
    return b;
}
DI void xcd_barrier_complete(unsigned* bar, unsigned x, unsigned& nloc, unsigned& nx) {
    const unsigned G = gridDim.x * gridDim.y * gridDim.z;
    unsigned sum, cnt, mine, sp = 0u;
    for (;;) {
        sum = 0u; cnt = 0u; mine = 0u;
#pragma unroll
        for (unsigned j = 0; j < 16; ++j) { const unsigned c = xb_ld(&bar[XB_XCNT(j)]); sum += c; cnt += (c > 0u) ? 1u : 0u; mine = (j == x) ? c : mine; }
        if (sum == G) break;
        __builtin_amdgcn_s_sleep(1);
        if ((++sp & 255u) == 0u) { if (xb_ld(&bar[XB_TMO])) break; if (sp > XB_SPIN_CAP) { atomicAdd(&bar[XB_TMO], 1u); break; } }
    }
    nloc = mine > 0u ? mine : 1u; nx = cnt > 0u ? cnt : 1u;
}
DI void xcd_barrier_slow(unsigned* bar, unsigned x, volatile LAS unsigned* st) {
    __builtin_amdgcn_s_waitcnt(0);
    unsigned nloc = st[0], nx = st[1];
    if (nloc == 0u) { xcd_barrier_complete(bar, x, nloc, nx); st[0] = nloc; st[1] = nx; }
    const unsigned old = xb_add(&bar[XB_XSUB(x)], 1u);
    const unsigned gen = old / nloc;
    if (old + 1u == (gen + 1u) * nloc) {
        __builtin_amdgcn_fence(__ATOMIC_RELEASE, "agent");
        asm volatile("s_waitcnt vmcnt(0)" ::: "memory");
        const unsigned og = xb_add(&bar[XB_TOP], 1u);
        const unsigned tg = og / nx;
        if (og + 1u == (tg + 1u) * nx) xb_add(&bar[XB_TOPGEN], 1u);
        else XB_SPIN(xb_ld(&bar[XB_TOPGEN]) == tg, bar);
        __builtin_amdgcn_fence(__ATOMIC_ACQUIRE, "agent");
        xb_add(&bar[XB_XGEN(x)], 1u);
        asm volatile("s_waitcnt vmcnt(0)" ::: "memory");
    } else {
        XB_SPIN(xb_ld(&bar[XB_XGEN(x)]) == gen, bar);
        __builtin_amdgcn_fence(__ATOMIC_ACQUIRE, "agent");
        asm volatile("s_waitcnt vmcnt(0)" ::: "memory");
    }
}
DI void xcd_barrier(const XcdBarrier& b) {
    asm volatile("s_waitcnt vmcnt(0)" ::: "memory");
    __syncthreads();
    if (threadIdx.x == 0) xcd_barrier_slow(b.bar, b.x, b.st);
    __syncthreads();
}

namespace pg8 {
constexpr int BM = 256, BK = 64, HALF = 128, HTB = HALF * BK * 2, STAGE_BYTES = 8 * HTB, NXCD = 8, WGM = 8;
DI int lds_byte(int r, int c) { const int st = (r >> 4) * 2 + (c >> 5), rr = r & 15, cc = c & 31, ob = rr * 64 + cc * 2; return st * 1024 + (ob ^ (((ob >> 9) & 1) << 5)); }
DI void stage_rc(int b, int& R, int& C) { const int st = b / 1024, sb = b % 1024, swz = sb ^ (((sb >> 9) & 1) << 5); R = (st >> 1) * 16 + swz / 64; C = (st & 1) * 32 + (swz % 64) / 2; }
DI int perm32(int rho) { const int n = rho >> 4, i = rho & 15; return 8 * (i >> 2) + 4 * n + (i & 3); }
struct Unit { int pm, pn, koff, slice; };
struct Gemm { const bf16_t* A; const bf16_t* Bt; int M, N, K, ld; };
struct StaticOrder {
    int nM, nN, nwg, G, c;
    DI void init(int M, int N, int G_, int c_) { nM = M / BM; nN = N / BM; nwg = nM * nN; G = G_; c = c_; }
    DI bool next(int i, Unit& u) const {
        const long L = (long)i * G + c; if (L >= nwg) return false;
        int wgid = (int)L; { const int q = nwg / NXCD, r = nwg % NXCD, xcd = wgid % NXCD, off = wgid / NXCD; wgid = (xcd < r ? xcd * (q + 1) : r * (q + 1) + (xcd - r) * q) + off; }
        const int nig = WGM * nN, gid = wgid / nig, fm = gid * WGM, gsz = (nM - fm) < WGM ? (nM - fm) : WGM;
        u.pm = fm + ((wgid % nig) % gsz); u.pn = (wgid % nig) / gsz; u.koff = 0; u.slice = 0; return true;
    }
};
struct MainOrder { int G, c; DI bool next(int i, Unit& u) const { const int L = i * G + c; if (L >= 256) return false; u.pm = L >> 2; u.pn = L & 3; u.koff = 0; u.slice = 0; return true; } };
struct TailOrder { int G, c, NS, klen; DI bool next(int i, Unit& u) const { const int L = i * G + c; if (L >= 16 * NS) return false; const int un = L / NS; u.slice = L - un * NS; u.pm = 64 + (un >> 2); u.pn = un & 3; u.koff = u.slice * klen; return true; } };
struct EpiBf16 {
    static constexpr bool PERM = true;
    bf16_t* O; int ldc;
    DI void operator()(const f32x4 (&acc)[2][2][4][2], const Unit& u, int wr, int wc, int fr, int fq) const {
        const int row0 = u.pm * BM + wr * 64 + fr, col0 = u.pn * BM + wc * 32 + 8 * fq;
#pragma unroll
        for (int ai = 0; ai < 2; ++ai)
#pragma unroll
            for (int m = 0; m < 4; ++m) { bf16_t* rowp = O + (size_t)(row0 + ai * HALF + m * 16) * ldc + col0;
#pragma unroll
                for (int bj = 0; bj < 2; ++bj) { const f32x4 v0 = acc[ai][bj][m][0], v1 = acc[ai][bj][m][1];
                    u32x4 w; w.x = pk_bf16(v0[0], v0[1]); w.y = pk_bf16(v0[2], v0[3]); w.z = pk_bf16(v1[0], v1[1]); w.w = pk_bf16(v1[2], v1[3]);
                    *(u32x4*)(rowp + bj * HALF) = w; } }
    }
};
struct EpiRes {
    static constexpr bool PERM = false;
    float* O; const float* resA; const float* resB; int split;
    DI void operator()(const f32x4 (&acc)[2][2][4][2], const Unit& u, int wr, int wc, int fr, int fq) const {
        const int row0 = u.pm * BM + wr * 64 + fr, col0 = u.pn * BM + wc * 32 + 4 * fq;
#pragma unroll
        for (int ai = 0; ai < 2; ++ai)
#pragma unroll
            for (int m = 0; m < 4; ++m) { const int r = row0 + ai * HALF + m * 16;
                const float* rp = (r < split ? resA + (size_t)r * 1024 : resB + (size_t)(r - split) * 1024) + col0; float* op = O + (size_t)r * 1024 + col0;
#pragma unroll
                for (int bj = 0; bj < 2; ++bj)
#pragma unroll
                    for (int n = 0; n < 2; ++n) *(f32x4*)(op + bj * HALF + n * 16) = acc[ai][bj][m][n] + *(const f32x4*)(rp + bj * HALF + n * 16); }
    }
};

struct EpiPart {
    static constexpr bool PERM = false;
    float* P;
    DI void operator()(const f32x4 (&acc)[2][2][4][2], const Unit& u, int wr, int wc, int fr, int fq) const {
        const int row0 = (u.pm - 64) * BM + wr * 64 + fr, col0 = u.pn * BM + wc * 32 + 4 * fq;
        float* base = P + (size_t)u.slice * 1048576;
#pragma unroll
        for (int ai = 0; ai < 2; ++ai)
#pragma unroll
            for (int m = 0; m < 4; ++m) { float* op = base + (size_t)(row0 + ai * HALF + m * 16) * 1024 + col0;
#pragma unroll
                for (int bj = 0; bj < 2; ++bj)
#pragma unroll
                    for (int n = 0; n < 2; ++n) *(f32x4*)(op + bj * HALF + n * 16) = acc[ai][bj][m][n]; }
    }
};

template <class Epi, class Sched>
DI void gemm_phase(LAS unsigned char* lds, const Gemm g, const Sched& S, const Epi& E) {
    const int tid = opaque_tid(), wid = __builtin_amdgcn_readfirstlane(tid >> 6), lane = tid & 63, wr = wid >> 2, wc = wid & 3, fr = lane & 15, fq = lane >> 4;
    const int K = g.ld, nt = g.K / BK;
    unsigned voffA[2], voffB[2];
#pragma unroll
    for (int i = 0; i < 2; ++i) { int R, C; stage_rc(tid * 16 + i * 8192, R, C); const int Rb = Epi::PERM ? ((R & ~31) + perm32(R & 31)) : R;
        voffA[i] = (unsigned)(R * K + C) * 2u; voffB[i] = (unsigned)(Rb * K + C) * 2u; }
    const size_t kstep = (size_t)(BK * 2);
    const size_t hstep = (size_t)HALF * K * 2;
    const size_t tstep = 2 * hstep;
    const unsigned ldsw = (unsigned)wid * 1024u;
    const int aoff = lds_byte(wr * 64 + fr, fq * 8), boff = lds_byte(wc * 32 + fr, fq * 8);
#define PG8_SA(b, h) (((b) * 2 + (h)) * HTB)
#define PG8_SB(b, h) ((4 + (b) * 2 + (h)) * HTB)
#define PG8_STAGE(bufoff, gbase, voff) do { _Pragma("unroll") for (int _i = 0; _i < 2; ++_i) \
        __builtin_amdgcn_global_load_lds((const unsigned*)((const char*)(gbase) + (voff)[_i]), (LAS unsigned*)(lds + (bufoff) + ldsw + _i * 8192), 16, 0, 0); } while (0)
#define PG8_LDA(dst, b, h) do { _Pragma("unroll") for (int m = 0; m < 4; ++m) _Pragma("unroll") for (int k = 0; k < 2; ++k) dst[m][k] = *(const LAS bf16x8*)(lds + PG8_SA(b, h) + aoff + m * 2048 + k * 1024); } while (0)
#define PG8_LDB(dst, b, h) do { _Pragma("unroll") for (int n = 0; n < 2; ++n) _Pragma("unroll") for (int k = 0; k < 2; ++k) dst[n][k] = *(const LAS bf16x8*)(lds + PG8_SB(b, h) + boff + n * 2048 + k * 1024); } while (0)
#define PG8_MMA(ai, bj, At, Bt) do { __builtin_amdgcn_s_setprio(1); _Pragma("unroll") for (int m = 0; m < 4; ++m) _Pragma("unroll") for (int n = 0; n < 2; ++n) _Pragma("unroll") for (int k = 0; k < 2; ++k) \
        acc[ai][bj][m][n] = __builtin_amdgcn_mfma_f32_16x16x32_bf16(Bt[n][k], At[m][k], acc[ai][bj][m][n], 0, 0, 0); __builtin_amdgcn_s_setprio(0); } while (0)
#define PG8_WAIT_V(n) asm volatile("s_waitcnt vmcnt(" #n ")" ::: "memory")
#define PG8_WAIT_L(n) asm volatile("s_waitcnt lgkmcnt(" #n ")" ::: "memory")
#define PG8_BAR __builtin_amdgcn_s_barrier()
#define PG8_SCHED __builtin_amdgcn_sched_barrier(0)
    Unit cur, nxt; int ui = 0;
    if (!S.next(0, cur)) return;
    f32x4 acc[2][2][4][2];
#pragma unroll
    for (int a = 0; a < 2; ++a)
#pragma unroll
        for (int b = 0; b < 2; ++b)
#pragma unroll
            for (int m = 0; m < 4; ++m)
#pragma unroll
                for (int n = 0; n < 2; ++n) acc[a][b][m][n] = (f32x4){0.f, 0.f, 0.f, 0.f};
    bf16x8 At[4][2], B0[2][2], B1[2][2];
    const char* cA = (const char*)g.A + (size_t)cur.pm * tstep + (size_t)cur.koff * 2; const char* cB = (const char*)g.Bt + (size_t)cur.pn * tstep + (size_t)cur.koff * 2;
    PG8_STAGE(PG8_SB(0, 0), cB, voffB); PG8_STAGE(PG8_SA(0, 0), cA, voffA); PG8_STAGE(PG8_SB(0, 1), cB + hstep, voffB); PG8_STAGE(PG8_SA(0, 1), cA + hstep, voffA);
    if (wr == 1) PG8_BAR;
    PG8_WAIT_V(4); PG8_BAR;
    PG8_STAGE(PG8_SB(1, 0), cB + kstep, voffB); PG8_STAGE(PG8_SA(1, 0), cA + kstep, voffA); PG8_STAGE(PG8_SB(1, 1), cB + hstep + kstep, voffB);
    PG8_WAIT_V(6); PG8_BAR;
    for (;;) {
        const bool has_next = S.next(ui + 1, nxt);
        const char* nA = has_next ? (const char*)g.A + (size_t)nxt.pm * tstep + (size_t)nxt.koff * 2 : cA; const char* nB = has_next ? (const char*)g.Bt + (size_t)nxt.pn * tstep + (size_t)nxt.koff * 2 : cB;
        for (int t = 0; t < nt; t += 2) {
            const bool last = (t == nt - 2);
            const char* a1 = cA + (size_t)(t + 1) * kstep;
            const char* a2 = last ? nA : cA + (size_t)(t + 2) * kstep; const char* b2 = last ? nB : cB + (size_t)(t + 2) * kstep;
            const char* a3 = a2 + kstep; const char* b3 = b2 + kstep;
            PG8_LDB(B0, 0, 0); PG8_SCHED; PG8_LDA(At, 0, 0); PG8_STAGE(PG8_SA(1, 1), a1 + hstep, voffA);
            PG8_WAIT_L(8); PG8_BAR; PG8_WAIT_L(0); PG8_MMA(0, 0, At, B0); PG8_BAR; PG8_SCHED;
            PG8_LDB(B1, 0, 1); PG8_STAGE(PG8_SB(0, 0), b2, voffB);
            PG8_BAR; PG8_WAIT_L(0); PG8_MMA(0, 1, At, B1); PG8_BAR;
            PG8_LDA(At, 0, 1); PG8_STAGE(PG8_SA(0, 0), a2, voffA);
            PG8_BAR; PG8_WAIT_L(0); PG8_MMA(1, 0, At, B0); PG8_BAR; PG8_SCHED;
            PG8_STAGE(PG8_SB(0, 1), b2 + hstep, voffB);
            PG8_WAIT_V(6); PG8_BAR; PG8_MMA(1, 1, At, B1); PG8_BAR;
            PG8_LDB(B0, 1, 0); PG8_SCHED; PG8_LDA(At, 1, 0); PG8_STAGE(PG8_SA(0, 1), a2 + hstep, voffA);
            PG8_WAIT_L(8); PG8_BAR; PG8_WAIT_L(0); PG8_MMA(0, 0, At, B0); PG8_BAR; PG8_SCHED;
            PG8_LDB(B1, 1, 1); PG8_STAGE(PG8_SB(1, 0), b3, voffB);
            PG8_BAR; PG8_WAIT_L(0); PG8_MMA(0, 1, At, B1); PG8_BAR;
            PG8_LDA(At, 1, 1); PG8_STAGE(PG8_SA(1, 0), a3, voffA);
            PG8_BAR; PG8_WAIT_L(0); PG8_MMA(1, 0, At, B0); PG8_BAR; PG8_SCHED;
            PG8_STAGE(PG8_SB(1, 1), b3 + hstep, voffB);
            PG8_WAIT_V(6); PG8_BAR; PG8_MMA(1, 1, At, B1); PG8_BAR;
        }
        E(acc, cur, wr, wc, fr, fq);
        if (!has_next) break;
#pragma unroll
        for (int a = 0; a < 2; ++a)
#pragma unroll
            for (int b = 0; b < 2; ++b)
#pragma unroll
                for (int m = 0; m < 4; ++m)
#pragma unroll
                    for (int n = 0; n < 2; ++n) acc[a][b][m][n] = (f32x4){0.f, 0.f, 0.f, 0.f};
        cur = nxt; cA = nA; cB = nB; ++ui;
    }
    PG8_WAIT_V(0);
    if (wr == 0) PG8_BAR;
    PG8_BAR;
#undef PG8_SA
#undef PG8_SB
#undef PG8_STAGE
#undef PG8_LDA
#undef PG8_LDB
#undef PG8_MMA
#undef PG8_WAIT_V
#undef PG8_WAIT_L
#undef PG8_BAR
#undef PG8_SCHED
}
}

DI void transpose_tile(const float* W, int ldw, int nvalid, int k0, int n0, bf16_t* Wt, int ldt, float* tile  ) {
    const int tid = threadIdx.x;
#pragma unroll
    for (int m = 0; m < 8; ++m) { const int e = tid + 512 * m, kk = e >> 6, nn = e & 63;
        tile[kk * 65 + nn] = (n0 + nn < nvalid) ? W[(size_t)(k0 + kk) * ldw + n0 + nn] : 0.f; }
    lds_barrier();
    { const int nn = tid >> 3, kq = tid & 7; float v[8];
#pragma unroll
      for (int j = 0; j < 8; ++j) v[j] = tile[(kq * 8 + j) * 65 + nn];
      u32x4 w; w.x = pk_bf16(v[0], v[1]); w.y = pk_bf16(v[2], v[3]); w.z = pk_bf16(v[4], v[5]); w.w = pk_bf16(v[6], v[7]);
      *(u32x4*)(Wt + (size_t)(n0 + nn) * ldt + k0 + kq * 8) = w; }
    lds_barrier();
}
DI void rmsnorm_bf16(const float* srcA, const float* srcB, int split, const float* w, bf16_t* out) {
    const int lane = threadIdx.x & 63, gw = blockIdx.x * 8 + (threadIdx.x >> 6), nw = gridDim.x * 8;
    for (int tok = gw; tok < T_TOK; tok += nw) {
        const float* src = tok < split ? srcA + (size_t)tok * 1024 : srcB + (size_t)(tok - split) * 1024;
        f32x4 v[4]; float ss = 0.f;
#pragma unroll
        for (int i = 0; i < 4; ++i) { v[i] = *(const f32x4*)(src + 4 * lane + 256 * i); ss += v[i].x * v[i].x + v[i].y * v[i].y + v[i].z * v[i].z + v[i].w * v[i].w; }
        ss = wave_sum(ss);
        const float rstd = rsqrtf(ss * (1.f / 1024.f) + 1e-6f);
#pragma unroll
        for (int i = 0; i < 4; ++i) { const f32x4 ww = *(const f32x4*)(w + 4 * lane + 256 * i);
            u32x2 o; o.x = pk_bf16(v[i].x * rstd * ww.x, v[i].y * rstd * ww.y); o.y = pk_bf16(v[i].z * rstd * ww.z, v[i].w * rstd * ww.w);
            *(u32x2*)(out + (size_t)tok * 1024 + 4 * lane + 256 * i) = o; }
    }
}
DI void phase_prep(const Params& p, unsigned char* smem) {
    float* tile = (float*)smem;
    bf16_t* wta = (bf16_t*)(p.ws + WS_WTA); bf16_t* wtoa = (bf16_t*)(p.ws + WS_WTOA); bf16_t* wtb = (bf16_t*)(p.ws + WS_WTB); bf16_t* wtob = (bf16_t*)(p.ws + WS_WTOB);
    for (int t = blockIdx.x; t < 3392; t += gridDim.x) {
        if (t < 1088) transpose_tile(p.w_in_a, 4112, 4112, (t & 15) * 64, (t >> 4) * 64, wta, 1024, tile);
        else if (t < 1344) { const int u = t - 1088; transpose_tile(p.w_out_a, 1024, 1024, (u & 15) * 64, (u >> 4) * 64, wtoa, 1024, tile); }
        else if (t < 2880) { const int u = t - 1344; transpose_tile(p.w_in_b, 6144, 6144, (u & 15) * 64, (u >> 4) * 64, wtb, 1024, tile); }
        else { const int u = t - 2880; transpose_tile(p.w_out_b, 1024, 1024, (u & 31) * 64, (u >> 5) * 64, wtob, 2048, tile); }
    }
    rmsnorm_bf16(p.xp, p.xs, T_PR, p.norm_w, (bf16_t*)(p.ws + WS_XN));
    for (int e = blockIdx.x * 512 + threadIdx.x; e < (64 + 32 + 8) * 128; e += gridDim.x * 512) {
        const int i = e & 127, r = e >> 7;
        const double inv = exp(-((double)i / 127.0) * 9.210340371976184);
        const double pos = r < 64 ? (double)r : r < 96 ? (double)((r - 64) * 64) : (double)(16384 + (r - 96));
        double sn, cs; sincos(pos * inv, &sn, &cs);
        f32x2* dst = (f32x2*)(p.ws + (r < 64 ? WS_TABR : r < 96 ? WS_TABC : WS_TABS)) + ((r < 64 ? r : r < 96 ? r - 64 : r - 96) * 128 + i);
        *dst = (f32x2){(float)cs, (float)sn};
    }
}

DI void phase_gdn_prep(const Params& p, unsigned char* smem) {
    float* ks = (float*)smem;
    float* vs = ks + 64 * 132;
    float* lowT = vs + 64 * 132;
    float* Gs = lowT + 64 * 68;
    float* Bs = Gs + 64;
    float* Es = Bs + 64;
    float* qs = Es + 64 + 64;
    float* solL = qs;
    const bf16_t* P0 = (const bf16_t*)(p.ws + WS_P0);
    const int tid = opaque_tid(), lane = tid & 63, wid = tid >> 6, hh = lane >> 5, l31 = lane & 31;
    for (int e = blockIdx.x * 512 + tid; e < (8 + 128) * 3 * 3072; e += gridDim.x * 512) {
        const int ch = e % 3072, r = (e / 3072) % 3, b = e / 9216;
        if (b < 8) p.out[O_GCP + (size_t)(b * 3 + r) * 3072 + ch] = bf2f(P0[(size_t)(b * 2048 + 2045 + r) * LDP0 + ch]);
        else { const int bb = b - 8; p.out[O_GCS + (size_t)(bb * 3 + r) * 3072 + ch] = bf2f(P0[(size_t)(T_PR + bb * 8 + 5 + r) * LDP0 + ch]); }
    }
    const int a_rg = tid / 96, a_cq = tid - a_rg * 96, a_sec = a_cq >> 5, a_c4 = (a_cq & 31) * 4, a_r0 = a_rg * 13;
    u32x2 xv[16];
#define GDN_LOAD_ROWS(it) do { const int n_ = (it) & 31, h_ = ((it) >> 5) & 7, b_ = (it) >> 8, col_ = a_sec * 1024 + h_ * 128 + a_c4; \
        _Pragma("unroll") for (int r = 0; r < 16; ++r) { const int rr = a_r0 + r - 3, tr = n_ * 64 + rr; \
            xv[r] = (a_rg < 5 && rr < 64 && tr >= 0) ? *(const u32x2*)(P0 + (size_t)(b_ * 2048 + tr) * LDP0 + col_) : (u32x2){0u, 0u}; } } while (0)
    if ((int)blockIdx.x < 2048) GDN_LOAD_ROWS((int)blockIdx.x);
    for (int item = blockIdx.x; item < 2048; item += gridDim.x) {
        const int n = item & 31, h = (item >> 5) & 7, b = item >> 8;
        const int tok0 = b * 2048 + n * 64;
        unsigned char* blk = p.ws + WS_GOP + (size_t)item * GOP_STRIDE;
        int tid_i = tid; asm volatile("" : "+v"(tid_i));
        const int tid = tid_i, lane = tid & 63, wid = tid >> 6, hh = lane >> 5, l31 = lane & 31;
        float braw = 0.f, araw = 0.f;
        if (wid == 1) { braw = bf2f(P0[(size_t)(tok0 + lane) * LDP0 + 4096 + h]); araw = bf2f(P0[(size_t)(tok0 + lane) * LDP0 + 4104 + h]); }
        bf16_t* o_nw = (bf16_t*)blk; bf16_t* o_qe = o_nw + 8192; bf16_t* o_kdT = o_qe + 8192; bf16_t* o_qkd = o_kdT + 8192; bf16_t* o_u0T = o_qkd + 4096;
        _Pragma("unroll") for (int rpA = 0; rpA <= ((PROBE_MASK >> 19) & 1); ++rpA)
        {
            const int rg = a_rg, sec = a_sec, c4 = a_c4, col = sec * 1024 + h * 128 + c4, r0 = a_r0;
            f32x4 w[4];
#pragma unroll
            for (int j = 0; j < 4; ++j) w[j] = *(const f32x4*)(p.conv_w + j * 3072 + col);
            float* dstb = (sec == 0 ? qs : sec == 1 ? ks : vs) + c4;
#pragma unroll
            for (int r = 0; r < 13; ++r) {
                float o0 = 0.f, o1 = 0.f, o2 = 0.f, o3 = 0.f;
#pragma unroll
                for (int j = 0; j < 4; ++j) { o0 += bflo(xv[r + j].x) * w[j].x; o1 += bfhi(xv[r + j].x) * w[j].y; o2 += bflo(xv[r + j].y) * w[j].z; o3 += bfhi(xv[r + j].y) * w[j].w; }
                o0 = silu_f(o0); o1 = silu_f(o1); o2 = silu_f(o2); o3 = silu_f(o3);
                float ss = row16_sum(o0 * o0 + o1 * o1 + o2 * o2 + o3 * o3);
                ss += __shfl_xor(ss, 16);
                float sc = 1.f;
                if (sec < 2) sc = rsqrtf(ss + 1e-6f) * (sec == 0 ? 0.08838834764831845f : 1.f);
                if (rg < 5 && r0 + r < 64) *(f32x4*)(dstb + (r0 + r) * 132) = (f32x4){o0 * sc, o1 * sc, o2 * sc, o3 * sc};
            }
        }
        lds_barrier();
        _Pragma("unroll") for (int rpC = 0; rpC <= ((PROBE_MASK >> 20) & 1); ++rpC) {
            const int which = wid >> 2, ti = (wid >> 1) & 1, tj = wid & 1;
            const float* Ap = (which ? qs : ks) + (32 * ti + l31) * 132 + 4 * hh;
            const float* Bp = ks + (32 * tj + l31) * 132 + 4 * hh;
            f32x16 acc;
#pragma unroll
            for (int i = 0; i < 16; ++i) acc[i] = 0.f;
            if (ti >= tj) {
#pragma unroll 4
                for (int k0 = 0; k0 < 128; k0 += 8) {
                    const f32x4 a = *(const f32x4*)(Ap + k0), bb = *(const f32x4*)(Bp + k0);
                    acc = __builtin_amdgcn_mfma_f32_32x32x2f32(a.x, bb.x, acc, 0, 0, 0);
                    acc = __builtin_amdgcn_mfma_f32_32x32x2f32(a.y, bb.y, acc, 0, 0, 0);
                    acc = __builtin_amdgcn_mfma_f32_32x32x2f32(a.z, bb.z, acc, 0, 0, 0);
                    acc = __builtin_amdgcn_mfma_f32_32x32x2f32(a.w, bb.w, acc, 0, 0, 0);
                }
            } else if (which == 0) {
                const float beta = 1.f / (1.f + expf(-braw));
                const float xx = araw + p.dt_bias[h];
                const float sp = xx > 20.f ? xx : log1pf(expf(xx));
                float g = -expf(p.a_log[h]) * sp;
#pragma unroll
                for (int d = 1; d < 64; d <<= 1) { const float t = __shfl_up(g, d); if (lane >= d) g += t; }
                Gs[lane] = g; Bs[lane] = beta; Es[lane] = expf(g);
            }
            lds_barrier();
            const int col = 32 * tj + l31; const float Gc = Gs[col];
#pragma unroll
            for (int i = 0; i < 16; ++i) {
                const int row = 32 * ti + crow(i, hh);
                const float dec = __expf(fminf(Gs[row] - Gc, 0.f));
                if (which == 0) lowT[col * 68 + row] = row > col ? Bs[row] * acc[i] * dec : 0.f;
                else { const int kk = col & 15; o_qkd[((((row >> 5) * 4 + (col >> 4)) * 64 + (row & 31) + 32 * ((kk >> 2) & 1)) << 3) + (kk & 3) + 4 * (kk >> 3)] = f2bf(row >= col ? acc[i] * dec : 0.f); }
            }
        }
        lds_barrier();
#pragma unroll
        for (int m = 0; m < 2; ++m) { const int e = tid + 512 * m, i = e >> 4, d0 = (e & 15) * 8; const float eg = Es[i]; const float* s = qs + i * 132 + d0;
            u32x2 w0, w1; w0.x = pk_bf16(s[0] * eg, s[1] * eg); w0.y = pk_bf16(s[2] * eg, s[3] * eg); w1.x = pk_bf16(s[4] * eg, s[5] * eg); w1.y = pk_bf16(s[6] * eg, s[7] * eg);
            bf16_t* fp = o_qe + ((((i >> 5) * 8 + (d0 >> 4)) * 64 + (i & 31)) << 3) + ((d0 >> 3) & 1) * 4;
            *(u32x2*)fp = w0; *(u32x2*)(fp + 32 * 8) = w1; }
        { const float GL = Gs[63];
#pragma unroll
          for (int m = 0; m < 2; ++m) { const int e = tid + 512 * m, d = e & 127, i0 = (e >> 7) * 8; float v[8];
#pragma unroll
            for (int j = 0; j < 8; ++j) v[j] = ks[(i0 + j) * 132 + d] * __expf(GL - Gs[i0 + j]);
            u32x2 w0, w1; w0.x = pk_bf16(v[0], v[1]); w0.y = pk_bf16(v[2], v[3]); w1.x = pk_bf16(v[4], v[5]); w1.y = pk_bf16(v[6], v[7]);
            bf16_t* fp = o_kdT + ((((d >> 5) * 4 + (i0 >> 4)) * 64 + (d & 31)) << 3) + ((i0 >> 3) & 1) * 4;
            *(u32x2*)fp = w0; *(u32x2*)(fp + 32 * 8) = w1; }
          if (tid == 0) *(float*)(blk + 73728) = expf(GL); }
        if (item + (int)gridDim.x < 2048) GDN_LOAD_ROWS(item + (int)gridDim.x);
        lds_barrier();
        _Pragma("unroll") for (int rpE = 0; rpE <= ((PROBE_MASK >> 18) & 1); ++rpE)
        {
            const int isk = wid >> 2, sl = wid & 3, c0 = sl * 32 + l31;
            const float* src = (isk ? ks : vs) + c0;
            f32x16 R[2];
#pragma unroll
            for (int rt = 0; rt < 2; ++rt)
#pragma unroll
                for (int i = 0; i < 16; ++i) { const int row = 32 * rt + crow(i, hh); R[rt][i] = Bs[row] * src[row * 132] * (isk ? Es[row] : 1.f); }
#pragma unroll
            for (int bI = 0; bI < 8; ++bI) {
                const int rt = bI >> 2, g = bI & 3;
                const int rA = 8 * bI + 4 * hh, rP = 8 * bI + 4 * (1 - hh);
                const float* tp = lowT + rA * 68 + rA;
                const float t10 = tp[1], t20 = tp[2], t30 = tp[3], t21 = tp[68 + 2], t31 = tp[68 + 3], t32 = tp[136 + 3];
                float a0 = R[rt][4 * g], a1 = R[rt][4 * g + 1], a2 = R[rt][4 * g + 2], a3 = R[rt][4 * g + 3];
                float x0 = a0, x1 = a1 - t10 * x0, x2 = a2 - t20 * x0 - t21 * x1, x3 = a3 - t30 * x0 - t31 * x1 - t32 * x2;
                const float y0 = __shfl_xor(x0, 32), y1 = __shfl_xor(x1, 32), y2 = __shfl_xor(x2, 32), y3 = __shfl_xor(x3, 32);
                const float* cq = lowT + rP * 68 + rA;
                a0 -= cq[0] * y0 + cq[68] * y1 + cq[136] * y2 + cq[204] * y3;
                a1 -= cq[1] * y0 + cq[68 + 1] * y1 + cq[136 + 1] * y2 + cq[204 + 1] * y3;
                a2 -= cq[2] * y0 + cq[68 + 2] * y1 + cq[136 + 2] * y2 + cq[204 + 2] * y3;
                a3 -= cq[3] * y0 + cq[68 + 3] * y1 + cq[136 + 3] * y2 + cq[204 + 3] * y3;
                x0 = a0; x1 = a1 - t10 * x0; x2 = a2 - t20 * x0 - t21 * x1; x3 = a3 - t30 * x0 - t31 * x1 - t32 * x2;
                if (isk) {
                    const int kk = c0 & 15; const float xs4[4] = {x0, x1, x2, x3};
#pragma unroll
                    for (int a = 0; a < 4; ++a) { const int row = rA + a;
                        o_nw[((((row >> 5) * 8 + (c0 >> 4)) * 64 + (row & 31) + 32 * ((kk >> 2) & 1)) << 3) + (kk & 3) + 4 * (kk >> 3)] = f2bf(-xs4[a]); }
                } else {
                    u32x2 w0; w0.x = pk_bf16(x0, x1); w0.y = pk_bf16(x2, x3);
                    *(u32x2*)(o_u0T + ((((sl * 2 + rt) * 64 + lane) << 4) + 4 * g)) = w0;
                }
#pragma unroll
                for (int rt2 = rt; rt2 < 2; ++rt2) {
                    if (rt2 == rt && g == 3) continue;
                    const float* ap = lowT + rA * 68 + 32 * rt2 + l31;
                    R[rt2] = __builtin_amdgcn_mfma_f32_32x32x2f32(ap[0], -x0, R[rt2], 0, 0, 0);
                    R[rt2] = __builtin_amdgcn_mfma_f32_32x32x2f32(ap[68], -x1, R[rt2], 0, 0, 0);
                    R[rt2] = __builtin_amdgcn_mfma_f32_32x32x2f32(ap[136], -x2, R[rt2], 0, 0, 0);
                    R[rt2] = __builtin_amdgcn_mfma_f32_32x32x2f32(ap[204], -x3, R[rt2], 0, 0, 0);
                }
                __builtin_amdgcn_sched_barrier(0);
            }
        }
        lds_barrier();
    }
}

#define LDSV(off) (*(const LAS bf16x8*)(base + (off)))
DI void gdn_scan_prompt(const Params& p, int bh, unsigned char* smem) {
    LAS unsigned char* lds = (LAS unsigned char*)smem;
    const int tid = opaque_tid(), lane = tid & 63, wid = __builtin_amdgcn_readfirstlane(tid >> 6), hh = lane >> 5, l31 = lane & 31;
    const int h = bh & 7, b = bh >> 3, s = wid;
    const unsigned char* gblk = p.ws + WS_GOP + (size_t)bh * 32 * GOP_STRIDE;
    bf16_t* oraw = (bf16_t*)(p.ws + WS_ORAW);
    f32x16 S[4];
#pragma unroll
    for (int t = 0; t < 4; ++t)
#pragma unroll
        for (int i = 0; i < 16; ++i) S[t][i] = 0.f;
    unsigned voff16 = lane * 16; asm volatile("" : "+v"(voff16));
#define GDN_DMA(n, buf) do { const unsigned char* g_ = gblk + (size_t)(n) * GOP_STRIDE; _Pragma("unroll") for (int i_ = 0; i_ < 18; ++i_) { const int pc_ = (wid - 4) + 4 * i_; \
        __builtin_amdgcn_global_load_lds((const unsigned*)((g_ + pc_ * 1024) + voff16), (LAS unsigned*)(lds + (buf) * 73728 + pc_ * 1024), 16, 0, 0); } } while (0)
#define GDN_BAR() do { asm volatile("" ::: "memory"); __builtin_amdgcn_s_barrier(); asm volatile("" ::: "memory"); } while (0)
    lds_barrier();
#define GDN_PF(n) do { const unsigned char* g_ = gblk + (size_t)(n) * GOP_STRIDE; _Pragma("unroll") for (int i_ = 0; i_ < 18; ++i_) { const int pc_ = (wid - 4) + 4 * i_; \
        __builtin_amdgcn_global_load_lds((const unsigned*)((g_ + pc_ * 1024) + voff16), (LAS unsigned*)(lds + 148480 + (wid - 4) * 1024), 16, 0, 0); } } while (0)
    if (wid >= 4) { GDN_DMA(0, 0); GDN_PF(1); GDN_PF(2); asm volatile("s_waitcnt vmcnt(0)" ::: "memory"); }
    GDN_BAR();
    for (int n = 0; n < 32; ++n) {
        if (wid >= 4 && n + 1 < 32) GDN_DMA(n + 1, (n + 1) & 1);
        if (wid >= 4 && n + 3 < 32) GDN_PF(n + 3);
        if (wid < 4) {
            LAS unsigned char* base = lds + (n & 1) * 73728 + lane * 16;
            const float dl = *(const float*)(gblk + (size_t)n * GOP_STRIDE + 73728);
            bf16x8 Ub[4];
            {
                f32x16 U[2];
#pragma unroll
                for (int rt = 0; rt < 2; ++rt) {
#pragma unroll
                    for (int g = 0; g < 2; ++g) { const u32x4 v = *(const LAS u32x4*)(lds + (n & 1) * 73728 + 57344 + (((s * 2 + rt) * 64 + lane) << 5) + 16 * g);
                        U[rt][8 * g] = bflo(v.x); U[rt][8 * g + 1] = bfhi(v.x); U[rt][8 * g + 2] = bflo(v.y); U[rt][8 * g + 3] = bfhi(v.y);
                        U[rt][8 * g + 4] = bflo(v.z); U[rt][8 * g + 5] = bfhi(v.z); U[rt][8 * g + 6] = bflo(v.w); U[rt][8 * g + 7] = bfhi(v.w); }
                }
#pragma unroll
                for (int t = 0; t < 4; ++t)
#pragma unroll
                    for (int s2 = 0; s2 < 2; ++s2) {
                        const bf16x8 sb = packB(S[t], s2);
#pragma unroll
                        for (int rt = 0; rt < 2; ++rt) U[rt] = MFMA32(LDSV((rt * 8 + 2 * t + s2) * 1024), sb, U[rt]);
                    }
#pragma unroll
                for (int kc = 0; kc < 4; ++kc) Ub[kc] = packB(U[kc >> 1], kc & 1);
            }
            f32x16 O[2];
#pragma unroll
            for (int rt = 0; rt < 2; ++rt)
#pragma unroll
                for (int i = 0; i < 16; ++i) O[rt][i] = 0.f;
#pragma unroll
            for (int t = 0; t < 4; ++t)
#pragma unroll
                for (int s2 = 0; s2 < 2; ++s2) {
                    const bf16x8 sb = packB(S[t], s2);
#pragma unroll
                    for (int rt = 0; rt < 2; ++rt) O[rt] = MFMA32(LDSV(16384 + (rt * 8 + 2 * t + s2) * 1024), sb, O[rt]);
                }
#pragma unroll
            for (int rt = 0; rt < 2; ++rt)
#pragma unroll
                for (int kc = 0; kc < 2 * rt + 2; ++kc) O[rt] = MFMA32(LDSV(49152 + (rt * 4 + kc) * 1024), Ub[kc], O[rt]);
            const size_t tok0 = (size_t)b * 2048 + n * 64;
#pragma unroll
            for (int rt = 0; rt < 2; ++rt)
#pragma unroll
                for (int i = 0; i < 16; ++i) oraw[(tok0 + 32 * rt + crow(i, hh)) * 1024 + h * 128 + 32 * s + l31] = f2bf(O[rt][i]);
#pragma unroll
            for (int t = 0; t < 4; ++t) {
#pragma unroll
                for (int i = 0; i < 16; ++i) S[t][i] *= dl;
#pragma unroll
                for (int kc = 0; kc < 4; ++kc) S[t] = MFMA32(LDSV(32768 + (t * 4 + kc) * 1024), Ub[kc], S[t]);
            }
        }
        if (wid >= 4) { if (n + 3 < 32) asm volatile("s_waitcnt vmcnt(18)" ::: "memory"); else asm volatile("s_waitcnt vmcnt(0)" ::: "memory"); }
        else asm volatile("s_waitcnt lgkmcnt(0)" ::: "memory");
        GDN_BAR();
    }
    lds_barrier();
#undef GDN_BAR
#undef GDN_PF
#undef GDN_DMA
    if (wid < 4) {
        float* so = p.out + O_GSP + (size_t)bh * 16384;
#pragma unroll
        for (int t = 0; t < 4; ++t)
#pragma unroll
            for (int i = 0; i < 16; ++i) so[(32 * t + crow(i, hh)) * 128 + 32 * s + l31] = S[t][i];
    }
}

DI void gdn_sample_item(const Params& p, int item, unsigned char* smem) {
    float* raw = (float*)smem;
    float* nwT = raw + 3072;
    float* qeT = nwT + 1024;
    float* kdT = qeT + 1024;
    float* u0 = kdT + 1024;
    float* lowm = u0 + 1024;
    float* qkm = lowm + 64;
    float* Gs = qkm + 64;
    float* part = Gs + 32;
    const bf16_t* P0 = (const bf16_t*)(p.ws + WS_P0);
    int tid_ = threadIdx.x; asm volatile("" : "+v"(tid_));
    const int tid = tid_, lane = tid & 63, wid = tid >> 6;
    const int h = item & 7, b = item >> 3, tok0 = T_PR + b * 8;
#pragma unroll
    for (int m = 0; m < 6; ++m) {
        const int e = tid + 512 * m, row = e / 384, c3 = e - row * 384, sec = c3 >> 7, col = sec * 1024 + h * 128 + (c3 & 127);
        float o = 0.f;
#pragma unroll
        for (int j = 0; j < 4; ++j) { const int tr = row - 3 + j;
            const float x = tr >= 0 ? bf2f(P0[(size_t)(tok0 + tr) * LDP0 + col]) : p.st_conv[(size_t)(b * 3 + (3 + tr)) * 3072 + col];
            o += x * p.conv_w[j * 3072 + col]; }
        raw[sec * 1024 + row * 128 + (c3 & 127)] = silu_f(o);
    }
    if (tid < 8) {
        const float braw = bf2f(P0[(size_t)(tok0 + tid) * LDP0 + 4096 + h]), araw = bf2f(P0[(size_t)(tok0 + tid) * LDP0 + 4104 + h]);
        const float xx = araw + p.dt_bias[h]; const float sp = xx > 20.f ? xx : log1pf(expf(xx));
        Gs[16 + tid] = -expf(p.a_log[h]) * sp;
        Gs[8 + tid] = 1.f / (1.f + expf(-braw));
    }
    lds_barrier();
    { float q0 = raw[wid * 128 + lane], q1 = raw[wid * 128 + 64 + lane], k0 = raw[1024 + wid * 128 + lane], k1 = raw[1024 + wid * 128 + 64 + lane];
      const float sq = wave_sum(q0 * q0 + q1 * q1), sk = wave_sum(k0 * k0 + k1 * k1);
      const float cq = rsqrtf(sq + 1e-6f) * 0.08838834764831845f, ck = rsqrtf(sk + 1e-6f);
      raw[wid * 128 + lane] = q0 * cq; raw[wid * 128 + 64 + lane] = q1 * cq; raw[1024 + wid * 128 + lane] = k0 * ck; raw[1024 + wid * 128 + 64 + lane] = k1 * ck; }
    if (tid == 0) { float a = 0.f; for (int i = 0; i < 8; ++i) { a += Gs[16 + i]; Gs[i] = a; } }
    lds_barrier();
    if (tid < 8) Gs[24 + tid] = expf(Gs[tid]);
    { const int i = wid; const float ki0 = raw[1024 + i * 128 + lane], ki1 = raw[1024 + i * 128 + 64 + lane], qi0 = raw[i * 128 + lane], qi1 = raw[i * 128 + 64 + lane];
      for (int j = 0; j <= i; ++j) { const float kj0 = raw[1024 + j * 128 + lane], kj1 = raw[1024 + j * 128 + 64 + lane];
          const float kk = wave_sum(ki0 * kj0 + ki1 * kj1), qk = wave_sum(qi0 * kj0 + qi1 * kj1);
          const float dec = expf(Gs[i] - Gs[j]);
          if (lane == 0) { lowm[i * 8 + j] = (j < i) ? Gs[8 + i] * kk * dec : 0.f; qkm[i * 8 + j] = qk * dec; } } }
    lds_barrier();
    if (tid < 256) {
        const int isk = tid >> 7, cc = tid & 127; float sol[8];
#pragma unroll
        for (int i = 0; i < 8; ++i) { float r = Gs[8 + i] * (isk ? Gs[24 + i] * raw[1024 + i * 128 + cc] : raw[2048 + i * 128 + cc]);
#pragma unroll
            for (int j = 0; j < i; ++j) r -= lowm[i * 8 + j] * sol[j];
            sol[i] = r; }
#pragma unroll
        for (int i = 0; i < 8; ++i) { if (isk) nwT[cc * 8 + i] = -sol[i]; else u0[i * 128 + cc] = sol[i]; }
    } else {
        const int t2 = tid - 256, which = t2 >> 7, d = t2 & 127;
#pragma unroll
        for (int i = 0; i < 8; ++i) { if (which == 0) qeT[d * 8 + i] = raw[i * 128 + d] * Gs[24 + i]; else kdT[d * 8 + i] = raw[1024 + i * 128 + d] * expf(Gs[7] - Gs[i]); }
    }
    lds_barrier();
    const int dv = tid & 127, qt = tid >> 7;
    const float* S0 = p.st_gdn + (size_t)item * 16384;
    float pu[8], po[8];
#pragma unroll
    for (int c = 0; c < 8; ++c) { pu[c] = 0.f; po[c] = 0.f; }
#pragma unroll 1
    for (int r0 = 0; r0 < 32; r0 += 16) {
        float sv[16];
#pragma unroll
        for (int r = 0; r < 16; ++r) sv[r] = S0[(32 * qt + r0 + r) * 128 + dv];
#pragma unroll
        for (int r = 0; r < 16; ++r) { const int dk = 32 * qt + r0 + r;
            const f32x4 w0 = *(const f32x4*)(nwT + dk * 8), w1 = *(const f32x4*)(nwT + dk * 8 + 4), e0 = *(const f32x4*)(qeT + dk * 8), e1 = *(const f32x4*)(qeT + dk * 8 + 4);
            const float s = sv[r];
            pu[0] += w0.x * s; pu[1] += w0.y * s; pu[2] += w0.z * s; pu[3] += w0.w * s; pu[4] += w1.x * s; pu[5] += w1.y * s; pu[6] += w1.z * s; pu[7] += w1.w * s;
            po[0] += e0.x * s; po[1] += e0.y * s; po[2] += e0.z * s; po[3] += e0.w * s; po[4] += e1.x * s; po[5] += e1.y * s; po[6] += e1.z * s; po[7] += e1.w * s; }
    }
#pragma unroll
    for (int c = 0; c < 8; ++c) { part[(qt * 8 + c) * 128 + dv] = pu[c]; part[4096 + (qt * 8 + c) * 128 + dv] = po[c]; }
    lds_barrier();
    float u[8];
#pragma unroll
    for (int c = 0; c < 8; ++c) u[c] = u0[c * 128 + dv] + part[c * 128 + dv] + part[(8 + c) * 128 + dv] + part[(16 + c) * 128 + dv] + part[(24 + c) * 128 + dv];
    if (qt == 0) {
        bf16_t* oraw = (bf16_t*)(p.ws + WS_ORAW);
#pragma unroll
        for (int c = 0; c < 8; ++c) { float o = part[4096 + c * 128 + dv] + part[4096 + (8 + c) * 128 + dv] + part[4096 + (16 + c) * 128 + dv] + part[4096 + (24 + c) * 128 + dv];
#pragma unroll
            for (int j = 0; j <= c; ++j) o += qkm[c * 8 + j] * u[j];
            oraw[(size_t)(tok0 + c) * 1024 + h * 128 + dv] = f2bf(o); }
    }
    { const float dl = Gs[24 + 7]; float* So = p.out + O_GSS + (size_t)item * 16384;
#pragma unroll 1
      for (int r0 = 0; r0 < 32; r0 += 16) {
          float sv[16];
#pragma unroll
          for (int r = 0; r < 16; ++r) sv[r] = S0[(32 * qt + r0 + r) * 128 + dv];
#pragma unroll
          for (int r = 0; r < 16; ++r) { const int dk = 32 * qt + r0 + r; const f32x4 k0 = *(const f32x4*)(kdT + dk * 8), k1 = *(const f32x4*)(kdT + dk * 8 + 4);
              So[dk * 128 + dv] = dl * sv[r] + k0.x * u[0] + k0.y * u[1] + k0.z * u[2] + k0.w * u[3] + k1.x * u[4] + k1.y * u[5] + k1.z * u[6] + k1.w * u[7]; }
      } }
    lds_barrier();
}
DI void phase_gdn_scan(const Params& p, unsigned char* smem) {
    const int nscan = 64;
    if ((int)blockIdx.x < nscan) {
        _Pragma("unroll") for (int rp = 0; rp <= ((PROBE_MASK >> 13) & 1); ++rp)
        for (int bh = blockIdx.x; bh < 64; bh += nscan) gdn_scan_prompt(p, bh, smem);
    } else {
        _Pragma("unroll") for (int rp = 0; rp <= ((PROBE_MASK >> 14) & 1); ++rp)
        for (int item = blockIdx.x - nscan; item < 1024; item += gridDim.x - nscan) gdn_sample_item(p, item, smem);
    }
}

DI void phase_gdn_gate(const Params& p) {
    const int lane = threadIdx.x & 63, gw = blockIdx.x * 8 + (threadIdx.x >> 6), nw = gridDim.x * 8;
    const bf16_t* oraw = (const bf16_t*)(p.ws + WS_ORAW); const bf16_t* P0 = (const bf16_t*)(p.ws + WS_P0); bf16_t* og = (bf16_t*)(p.ws + WS_OG);
    for (int tok = gw; tok < T_TOK; tok += nw) {
        const u32x4 a0 = *(const u32x4*)(oraw + (size_t)tok * 1024 + 16 * lane), a1 = *(const u32x4*)(oraw + (size_t)tok * 1024 + 16 * lane + 8);
        const u32x4 z0 = *(const u32x4*)(P0 + (size_t)tok * LDP0 + 3072 + 16 * lane), z1 = *(const u32x4*)(P0 + (size_t)tok * LDP0 + 3072 + 16 * lane + 8);
        float o[16], z[16];
        const unsigned au[8] = {a0.x, a0.y, a0.z, a0.w, a1.x, a1.y, a1.z, a1.w}, zu[8] = {z0.x, z0.y, z0.z, z0.w, z1.x, z1.y, z1.z, z1.w};
        float ss = 0.f;
#pragma unroll
        for (int i = 0; i < 8; ++i) { o[2 * i] = bflo(au[i]); o[2 * i + 1] = bfhi(au[i]); z[2 * i] = bflo(zu[i]); z[2 * i + 1] = bfhi(zu[i]); ss += o[2 * i] * o[2 * i] + o[2 * i + 1] * o[2 * i + 1]; }
        ss += __shfl_xor(ss, 1); ss += __shfl_xor(ss, 2); ss += __shfl_xor(ss, 4);
        const float rstd = rsqrtf(ss * (1.f / 128.f) + 1e-6f);
        const int d0 = (16 * lane) & 127;
        unsigned r[8];
#pragma unroll
        for (int i = 0; i < 8; ++i) { const float v0 = o[2 * i] * rstd * p.onorm_a[d0 + 2 * i] * silu_f(z[2 * i]), v1 = o[2 * i + 1] * rstd * p.onorm_a[d0 + 2 * i + 1] * silu_f(z[2 * i + 1]); r[i] = pk_bf16(v0, v1); }
        *(u32x4*)(og + (size_t)tok * 1024 + 16 * lane) = (u32x4){r[0], r[1], r[2], r[3]};
        *(u32x4*)(og + (size_t)tok * 1024 + 16 * lane + 8) = (u32x4){r[4], r[5], r[6], r[7]};
    }
}

DI float ret_lg(int h) { return log1pf(-exp2f(-5.f - (float)h)); }
DI void rot_angle(double pos, double inv, float& sn, float& cs) {
    const double rev = pos * inv * 0.15915494309189535; const float fr = (float)(rev - rint(rev));
    sincosf(fr * 6.283185307179586f, &sn, &cs);
}
DI void phase_ret_prep(const Params& p, unsigned char* smem) {
    bf16_t* qr = (bf16_t*)smem;
    bf16_t* kr = qr + 64 * 264;
    bf16_t* vs = kr + 64 * 264;
    const bf16_t* P1 = (const bf16_t*)(p.ws + WS_P1);
    const f32x2* tabR = (const f32x2*)(p.ws + WS_TABR); const f32x2* tabC = (const f32x2*)(p.ws + WS_TABC);
    const int tid = opaque_tid(), lane = tid & 63, wid = tid >> 6, hh = lane >> 5, l31 = lane & 31;
    for (int item = blockIdx.x; item < 1024; item += gridDim.x) {
        const int n = item & 31, h = (item >> 5) & 3, b = item >> 7;
        const int tok0 = b * 2048 + n * 64;
        const float lg = ret_lg(h);
        unsigned char* blk = p.ws + WS_ROP + (size_t)item * ROP_STRIDE;
        bf16_t* o_qd = (bf16_t*)blk; bf16_t* o_kdT = o_qd + 16384; bf16_t* o_qkD = o_kdT + 16384; bf16_t* o_vT = o_qkD + 4096;
        u32x4 vreg[8];
#pragma unroll
        for (int m = 0; m < 8; ++m) { const int e = tid + 512 * m, row = (e >> 5) & 63, c8 = (e & 31) * 8, half = e >> 11;
            vreg[m] = *(const u32x4*)(P1 + (size_t)(tok0 + row) * LDP1 + 2048 + h * 512 + half * 256 + c8); }
#pragma unroll
        for (int m = 0; m < 2; ++m) {
            const int e = tid + 512 * m, row = e >> 4, i0 = (e & 15) * 8;
            const bf16_t* src = P1 + (size_t)(tok0 + row) * LDP1 + h * 256 + i0;
            const u32x4 q1 = *(const u32x4*)src, q2 = *(const u32x4*)(src + 128), k1 = *(const u32x4*)(src + 1024), k2 = *(const u32x4*)(src + 1152);
            const unsigned q1u[4] = {q1.x, q1.y, q1.z, q1.w}, q2u[4] = {q2.x, q2.y, q2.z, q2.w}, k1u[4] = {k1.x, k1.y, k1.z, k1.w}, k2u[4] = {k2.x, k2.y, k2.z, k2.w};
            float qa[8], qb[8], ka[8], kb[8];
#pragma unroll
            for (int j = 0; j < 8; ++j) {
                const f32x2 tr = tabR[row * 128 + i0 + j], tc = tabC[n * 128 + i0 + j];
                const float cs = tc.x * tr.x - tc.y * tr.y, sn = tc.y * tr.x + tc.x * tr.y;
                const float x1 = (j & 1) ? bfhi(q1u[j >> 1]) : bflo(q1u[j >> 1]), x2 = (j & 1) ? bfhi(q2u[j >> 1]) : bflo(q2u[j >> 1]);
                const float y1 = (j & 1) ? bfhi(k1u[j >> 1]) : bflo(k1u[j >> 1]), y2 = (j & 1) ? bfhi(k2u[j >> 1]) : bflo(k2u[j >> 1]);
                qa[j] = x1 * cs - x2 * sn; qb[j] = x1 * sn + x2 * cs;
                ka[j] = (y1 * cs - y2 * sn) * 0.0625f; kb[j] = (y1 * sn + y2 * cs) * 0.0625f;
            }
            const float qdec = expf(lg * (float)(row + 1));
            u32x4 w;
            w.x = pk_bf16(qa[0], qa[1]); w.y = pk_bf16(qa[2], qa[3]); w.z = pk_bf16(qa[4], qa[5]); w.w = pk_bf16(qa[6], qa[7]); *(u32x4*)(qr + row * 264 + i0) = w;
            w.x = pk_bf16(qb[0], qb[1]); w.y = pk_bf16(qb[2], qb[3]); w.z = pk_bf16(qb[4], qb[5]); w.w = pk_bf16(qb[6], qb[7]); *(u32x4*)(qr + row * 264 + 128 + i0) = w;
            w.x = pk_bf16(ka[0], ka[1]); w.y = pk_bf16(ka[2], ka[3]); w.z = pk_bf16(ka[4], ka[5]); w.w = pk_bf16(ka[6], ka[7]); *(u32x4*)(kr + row * 264 + i0) = w;
            w.x = pk_bf16(kb[0], kb[1]); w.y = pk_bf16(kb[2], kb[3]); w.z = pk_bf16(kb[4], kb[5]); w.w = pk_bf16(kb[6], kb[7]); *(u32x4*)(kr + row * 264 + 128 + i0) = w;
            { u32x2 w0, w1; bf16_t* fp = o_qd + ((((row >> 5) * 16 + (i0 >> 4)) * 64 + (row & 31)) << 3) + ((i0 >> 3) & 1) * 4;
              w0.x = pk_bf16(qa[0] * qdec, qa[1] * qdec); w0.y = pk_bf16(qa[2] * qdec, qa[3] * qdec); w1.x = pk_bf16(qa[4] * qdec, qa[5] * qdec); w1.y = pk_bf16(qa[6] * qdec, qa[7] * qdec);
              *(u32x2*)fp = w0; *(u32x2*)(fp + 32 * 8) = w1;
              w0.x = pk_bf16(qb[0] * qdec, qb[1] * qdec); w0.y = pk_bf16(qb[2] * qdec, qb[3] * qdec); w1.x = pk_bf16(qb[4] * qdec, qb[5] * qdec); w1.y = pk_bf16(qb[6] * qdec, qb[7] * qdec);
              *(u32x2*)(fp + 8 * 64 * 8) = w0; *(u32x2*)(fp + 8 * 64 * 8 + 32 * 8) = w1; }
        }
#pragma unroll
        for (int m = 0; m < 8; ++m) { const int e = tid + 512 * m, row = (e >> 5) & 63, c8 = (e & 31) * 8, half = e >> 11;
            *(u32x4*)(vs + half * (64 * 264) + row * 264 + c8) = vreg[m]; }
        lds_barrier();
        if (wid < 4) {
            const int ti = wid >> 1, tj = wid & 1;
            f32x16 acc;
#pragma unroll
            for (int i = 0; i < 16; ++i) acc[i] = 0.f;
            if (ti >= tj) {
#pragma unroll 4
                for (int ksp = 0; ksp < 16; ++ksp)
                    acc = MFMA32(ld16(qr + (32 * ti + l31) * 264 + 16 * ksp + 8 * hh), ld16(kr + (32 * tj + l31) * 264 + 16 * ksp + 8 * hh), acc);
            }
            const int col = 32 * tj + l31;
#pragma unroll
            for (int i = 0; i < 16; ++i) { const int row = 32 * ti + crow(i, hh);
                o_qkD[((((row >> 5) * 4 + (col >> 4)) * 64 + (row & 31) + 32 * ((col >> 3) & 1)) << 3) + (col & 7)] = f2bf(row >= col ? acc[i] * __expf(lg * (float)(row - col)) : 0.f); }
        } else {
            const int dk = tid - 256;
#pragma unroll
            for (int i0 = 0; i0 < 64; i0 += 8) { float v[8];
#pragma unroll
                for (int j = 0; j < 8; ++j) v[j] = bf2f(kr[(i0 + j) * 264 + dk]) * __expf(lg * (float)(63 - i0 - j));
                u32x4 w; w.x = pk_bf16(v[0], v[1]); w.y = pk_bf16(v[2], v[3]); w.z = pk_bf16(v[4], v[5]); w.w = pk_bf16(v[6], v[7]);
                *(u32x4*)(o_kdT + ((((dk >> 5) * 4 + (i0 >> 4)) * 64 + (dk & 31) + 32 * ((i0 >> 3) & 1)) << 3)) = w; }
        }
#pragma unroll
        for (int m = 0; m < 8; ++m) { const int e = tid + 512 * m, dv = e & 511, i0 = (e >> 9) * 8; unsigned short v[8];
            const bf16_t* vp = vs + (dv >> 8) * (64 * 264) + (dv & 255);
#pragma unroll
            for (int j = 0; j < 8; ++j) v[j] = vp[(i0 + j) * 264];
            u32x4 w; w.x = v[0] | ((unsigned)v[1] << 16); w.y = v[2] | ((unsigned)v[3] << 16); w.z = v[4] | ((unsigned)v[5] << 16); w.w = v[6] | ((unsigned)v[7] << 16);
            *(u32x4*)(o_vT + ((((dv >> 5) * 4 + (i0 >> 4)) * 64 + (dv & 31) + 32 * ((i0 >> 3) & 1)) << 3)) = w; }
        lds_barrier();
    }
}

DI void ret_scan_prompt(const Params& p, int item, unsigned char* smem) {
    LAS unsigned char* lds = (LAS unsigned char*)smem;
    const int tid = opaque_tid(), lane = tid & 63, wid = __builtin_amdgcn_readfirstlane(tid >> 6), hh = lane >> 5, l31 = lane & 31;
    const int half = item & 1, bh = item >> 1, h = bh & 3, b = bh >> 2, s = half * 8 + wid;
    const float sdec = expf(ret_lg(h) * 64.f);
    const unsigned char* gblk = p.ws + WS_ROP + (size_t)bh * 32 * ROP_STRIDE;
    bf16_t* oraw = (bf16_t*)(p.ws + WS_ORAW);
    LAS unsigned char* base = lds + lane * 16;
    f32x16 S[8];
#pragma unroll
    for (int t = 0; t < 8; ++t)
#pragma unroll
        for (int i = 0; i < 16; ++i) S[t][i] = 0.f;
    unsigned voff16 = lane * 16; asm volatile("" : "+v"(voff16));
#define RET_CP(goff, loff, npc) do { _Pragma("unroll") for (int i_ = 0; i_ < (npc); ++i_) { const int pc_ = wid + 8 * i_; \
        __builtin_amdgcn_global_load_lds((const unsigned*)((g_ + (goff) + pc_ * 1024) + voff16), (LAS unsigned*)(lds + (loff) + pc_ * 1024), 16, 0, 0); } } while (0)
#define RET_DMA_A(n) do { const unsigned char* g_ = gblk + (size_t)(n) * ROP_STRIDE; RET_CP(0, 0, 4); RET_CP(65536, 32768, 1); RET_CP(73728 + half * 32768, 73728 + ((n) & 1) * 32768, 4); } while (0)
#define RET_DMA_B(n) do { const unsigned char* g_ = gblk + (size_t)(n) * ROP_STRIDE; RET_CP(32768, 40960, 4); } while (0)
    lds_barrier();
    RET_DMA_A(0);
    asm volatile("s_waitcnt vmcnt(0)" ::: "memory"); lds_barrier();
    for (int n = 0; n < 32; ++n) {
        RET_DMA_B(n);
        f32x16 O[2];
#pragma unroll
        for (int rt = 0; rt < 2; ++rt)
#pragma unroll
            for (int i = 0; i < 16; ++i) O[rt][i] = 0.f;
        const int voff = 73728 + (n & 1) * 32768 + wid * 4096;
#pragma unroll
        for (int t = 0; t < 8; ++t)
#pragma unroll
            for (int s2 = 0; s2 < 2; ++s2) {
                const bf16x8 sb = packB(S[t], s2);
#pragma unroll
                for (int rt = 0; rt < 2; ++rt) O[rt] = MFMA32(LDSV((rt * 16 + 2 * t + s2) * 1024), sb, O[rt]);
                if (s2 == 1 && (t & 1)) __builtin_amdgcn_sched_barrier(0);
            }
#pragma unroll
        for (int rt = 0; rt < 2; ++rt)
#pragma unroll
            for (int kc = 0; kc < 2 * rt + 2; ++kc) O[rt] = MFMA32(LDSV(32768 + (rt * 4 + kc) * 1024), LDSV(voff + kc * 1024), O[rt]);
        const size_t tok0 = (size_t)b * 2048 + n * 64;
#pragma unroll
        for (int rt = 0; rt < 2; ++rt)
#pragma unroll
            for (int i = 0; i < 16; ++i) oraw[(tok0 + 32 * rt + crow(i, hh)) * 2048 + h * 512 + 32 * s + l31] = f2bf(O[rt][i]);
        asm volatile("s_waitcnt vmcnt(0)" ::: "memory"); lds_barrier();
        if (n + 1 < 32) RET_DMA_A(n + 1);
        bf16x8 Vb[4];
#pragma unroll
        for (int kc = 0; kc < 4; ++kc) Vb[kc] = LDSV(voff + kc * 1024);
#pragma unroll
        for (int t = 0; t < 8; ++t) {
#pragma unroll
            for (int i = 0; i < 16; ++i) S[t][i] *= sdec;
#pragma unroll
            for (int kc = 0; kc < 4; ++kc) S[t] = MFMA32(LDSV(40960 + (t * 4 + kc) * 1024), Vb[kc], S[t]);
            if (t & 1) __builtin_amdgcn_sched_barrier(0);
        }
        asm volatile("s_waitcnt vmcnt(0)" ::: "memory"); lds_barrier();
    }
#undef RET_CP
#undef RET_DMA_A
#undef RET_DMA_B
    float* so = p.out + O_RP + (size_t)bh * 131072;
#pragma unroll
    for (int t = 0; t < 8; ++t)
#pragma unroll
        for (int i = 0; i < 16; ++i) so[(32 * t + crow(i, hh)) * 512 + 32 * s + l31] = S[t][i];
}
DI void ret_sample_item(const Params& p, int item, unsigned char* smem) {
    float* qT = (float*)smem;
    float* kT = qT + 2048;
    float* qraw = kT + 2048;
    float* kraw = qraw + 2048;
    float* qkm = kraw + 2048;
    const bf16_t* P1 = (const bf16_t*)(p.ws + WS_P1);
    int tid_ = threadIdx.x; asm volatile("" : "+v"(tid_));
    const int tid = tid_, lane = tid & 63, wid = tid >> 6;
    const int h = item & 3, b = item >> 2, tok0 = T_PR + b * 8;
    const float lg = ret_lg(h);
#pragma unroll
    for (int m = 0; m < 2; ++m) {
        const int e = tid + 512 * m, row = e >> 7, i = e & 127;
        const f32x2 tsv = ((const f32x2*)(p.ws + WS_TABS))[row * 128 + i]; const float cs = tsv.x, sn = tsv.y;
        const bf16_t* src = P1 + (size_t)(tok0 + row) * LDP1 + h * 256 + i;
        const float x1 = bf2f(src[0]), x2 = bf2f(src[128]), y1 = bf2f(src[1024]), y2 = bf2f(src[1152]);
        const float qa = x1 * cs - x2 * sn, qb = x1 * sn + x2 * cs, ka = (y1 * cs - y2 * sn) * 0.0625f, kb = (y1 * sn + y2 * cs) * 0.0625f;
        const float qdec = expf(lg * (float)(row + 1)), kdec = expf(lg * (float)(7 - row));
        qraw[row * 256 + i] = qa; qraw[row * 256 + 128 + i] = qb; kraw[row * 256 + i] = ka; kraw[row * 256 + 128 + i] = kb;
        qT[i * 8 + row] = qa * qdec; qT[(128 + i) * 8 + row] = qb * qdec; kT[i * 8 + row] = ka * kdec; kT[(128 + i) * 8 + row] = kb * kdec;
    }
    lds_barrier();
    { const int i = wid;
      for (int j = 0; j <= i; ++j) { float a = 0.f;
#pragma unroll
          for (int q = 0; q < 4; ++q) a += qraw[i * 256 + lane + 64 * q] * kraw[j * 256 + lane + 64 * q];
          a = wave_sum(a);
          if (lane == 0) qkm[i * 8 + j] = a * expf(lg * (float)(i - j)); } }
    lds_barrier();
    float* red = (float*)(smem + 40960);
    float* vsh = (float*)(smem + 106496);
    const int dv4 = tid & 127, dkq = tid >> 7;
    f32x4 v[8], ao[8];
#pragma unroll
    for (int c = 0; c < 8; ++c) { const u32x2 vv = *(const u32x2*)(P1 + (size_t)(tok0 + c) * LDP1 + 2048 + h * 512 + 4 * dv4);
        v[c] = (f32x4){bflo(vv.x), bfhi(vv.x), bflo(vv.y), bfhi(vv.y)}; ao[c] = (f32x4){0.f, 0.f, 0.f, 0.f};
        if (dkq == 0) *(f32x4*)(vsh + c * 512 + 4 * dv4) = v[c]; }
    const float sdec = expf(lg * 8.f);
    const float* S0 = p.st_ret + (size_t)item * 131072 + 4 * dv4; float* So = p.out + O_RS + (size_t)item * 131072 + 4 * dv4;
#pragma unroll 1
    for (int dk0 = 64 * dkq; dk0 < 64 * dkq + 64; dk0 += 16) {
        f32x4 sv[16];
#pragma unroll
        for (int r = 0; r < 16; ++r) sv[r] = __builtin_nontemporal_load((const f32x4*)(S0 + (size_t)(dk0 + r) * 512));
#pragma unroll
        for (int r = 0; r < 16; ++r) { const int dk = dk0 + r;
            const f32x4 q0 = *(const f32x4*)(qT + dk * 8), q1 = *(const f32x4*)(qT + dk * 8 + 4), k0 = *(const f32x4*)(kT + dk * 8), k1 = *(const f32x4*)(kT + dk * 8 + 4);
            const f32x4 s = sv[r];
            ao[0] += q0.x * s; ao[1] += q0.y * s; ao[2] += q0.z * s; ao[3] += q0.w * s; ao[4] += q1.x * s; ao[5] += q1.y * s; ao[6] += q1.z * s; ao[7] += q1.w * s;
            const f32x4 sn = sdec * s + k0.x * v[0] + k0.y * v[1] + k0.z * v[2] + k0.w * v[3] + k1.x * v[4] + k1.y * v[5] + k1.z * v[6] + k1.w * v[7];
            __builtin_nontemporal_store(sn, (f32x4*)(So + (size_t)dk * 512)); }
    }
#pragma unroll
    for (int c = 0; c < 8; ++c) *(f32x4*)(red + (dkq * 8 + c) * 512 + 4 * dv4) = ao[c];
    lds_barrier();
    bf16_t* oraw = (bf16_t*)(p.ws + WS_ORAW);
    { const int dv = tid; float vc[8];
#pragma unroll
      for (int c = 0; c < 8; ++c) vc[c] = vsh[c * 512 + dv];
#pragma unroll
      for (int c = 0; c < 8; ++c) { float o = red[c * 512 + dv] + red[(8 + c) * 512 + dv] + red[(16 + c) * 512 + dv] + red[(24 + c) * 512 + dv];
#pragma unroll
          for (int j = 0; j <= c; ++j) o += qkm[c * 8 + j] * vc[j];
          oraw[(size_t)(tok0 + c) * 2048 + h * 512 + dv] = f2bf(o); } }
    lds_barrier();
}
DI void phase_ret_scan(const Params& p, unsigned char* smem) {
    const int nscan = 64;
    if ((int)blockIdx.x < nscan) {
        _Pragma("unroll") for (int rp = 0; rp <= ((PROBE_MASK >> 15) & 1); ++rp)
        for (int item = blockIdx.x; item < 64; item += nscan) ret_scan_prompt(p, item, smem);
    } else {
        _Pragma("unroll") for (int rp = 0; rp <= ((PROBE_MASK >> 16) & 1); ++rp)
        for (int item = blockIdx.x - nscan; item < 512; item += gridDim.x - nscan) ret_sample_item(p, item, smem);
    }
}

DI void phase_ret_gate(const Params& p) {
    const int lane = threadIdx.x & 63, gw = blockIdx.x * 8 + (threadIdx.x >> 6), nw = gridDim.x * 8;
    const bf16_t* oraw = (const bf16_t*)(p.ws + WS_ORAW); const bf16_t* P1 = (const bf16_t*)(p.ws + WS_P1); bf16_t* og = (bf16_t*)(p.ws + WS_OG);
    for (int tok = gw; tok < T_TOK; tok += nw) {
        float o[32]; float ss = 0.f;
#pragma unroll
        for (int q = 0; q < 4; ++q) { const u32x4 a = *(const u32x4*)(oraw + (size_t)tok * 2048 + 32 * lane + 8 * q); const unsigned au[4] = {a.x, a.y, a.z, a.w};
#pragma unroll
            for (int i = 0; i < 4; ++i) { o[8 * q + 2 * i] = bflo(au[i]); o[8 * q + 2 * i + 1] = bfhi(au[i]); ss += o[8 * q + 2 * i] * o[8 * q + 2 * i] + o[8 * q + 2 * i + 1] * o[8 * q + 2 * i + 1]; } }
        ss = row16_sum(ss);
        const float rstd = rsqrtf(ss * (1.f / 512.f) + 1e-6f);
        const float* wn = p.onorm_b + 32 * lane;
#pragma unroll
        for (int q = 0; q < 4; ++q) { const u32x4 g = *(const u32x4*)(P1 + (size_t)tok * LDP1 + 4096 + 32 * lane + 8 * q); const unsigned gu[4] = {g.x, g.y, g.z, g.w}; unsigned r[4];
#pragma unroll
            for (int i = 0; i < 4; ++i) { const float v0 = o[8 * q + 2 * i] * rstd * wn[8 * q + 2 * i] * silu_f(bflo(gu[i])), v1 = o[8 * q + 2 * i + 1] * rstd * wn[8 * q + 2 * i + 1] * silu_f(bfhi(gu[i])); r[i] = pk_bf16(v0, v1); }
            *(u32x4*)(og + (size_t)tok * 2048 + 32 * lane + 8 * q) = (u32x4){r[0], r[1], r[2], r[3]}; }
    }
}

DI void phase_norm1(const Params& p) {
    const int lane = threadIdx.x & 63, gw = blockIdx.x * 8 + (threadIdx.x >> 6), nw = gridDim.x * 8;
    float* x1 = (float*)(p.ws + WS_X1); const float* part = (const float*)(p.ws + WS_PART1); bf16_t* out = (bf16_t*)(p.ws + WS_XN); const float* w = p.norm_w + 1024;
    for (int tok = gw; tok < T_TOK; tok += nw) {
        f32x4 v[4]; float ss = 0.f;
#pragma unroll
        for (int i = 0; i < 4; ++i) { const int c = 4 * lane + 256 * i;
            if (tok < T_PR) v[i] = *(const f32x4*)(x1 + (size_t)tok * 1024 + c);
            else { const size_t o = (size_t)(tok - T_PR) * 1024 + c; v[i] = *(const f32x4*)(p.xs + o);
#pragma unroll
                for (int s = 0; s < 4; ++s) v[i] += *(const f32x4*)(part + (size_t)s * 1048576 + o);
                *(f32x4*)(x1 + (size_t)tok * 1024 + c) = v[i]; }
            ss += v[i].x * v[i].x + v[i].y * v[i].y + v[i].z * v[i].z + v[i].w * v[i].w; }
        ss = wave_sum(ss);
        const float rstd = rsqrtf(ss * (1.f / 1024.f) + 1e-6f);
#pragma unroll
        for (int i = 0; i < 4; ++i) { const f32x4 ww = *(const f32x4*)(w + 4 * lane + 256 * i);
            u32x2 o; o.x = pk_bf16(v[i].x * rstd * ww.x, v[i].y * rstd * ww.y); o.y = pk_bf16(v[i].z * rstd * ww.z, v[i].w * rstd * ww.w);
            *(u32x2*)(out + (size_t)tok * 1024 + 4 * lane + 256 * i) = o; }
    }
}

DI void phase_final(const Params& p) {
    const int lane = threadIdx.x & 63, gw = blockIdx.x * 8 + (threadIdx.x >> 6), nw = gridDim.x * 8;
    const float* x2 = (const float*)(p.ws + WS_X2);
    for (int tok = gw; tok < T_TOK; tok += nw) {
        f32x4 v[4]; float ss = 0.f;
#pragma unroll
        for (int i = 0; i < 4; ++i) { const int c = 4 * lane + 256 * i;
            if (tok < T_PR) v[i] = *(const f32x4*)(x2 + (size_t)tok * 1024 + c);
            else { const size_t o = (size_t)(tok - T_PR) * 1024 + c; v[i] = *(const f32x4*)((const float*)(p.ws + WS_X1) + (size_t)tok * 1024 + c);
#pragma unroll
                for (int s = 0; s < 8; ++s) v[i] += *(const f32x4*)((const float*)(p.ws + WS_PART2) + (size_t)s * 1048576 + o); }
            ss += v[i].x * v[i].x + v[i].y * v[i].y + v[i].z * v[i].z + v[i].w * v[i].w; }
        ss = wave_sum(ss);
        const float rstd = rsqrtf(ss * (1.f / 1024.f) + 1e-6f);
#pragma unroll
        for (int i = 0; i < 4; ++i) { const f32x4 ww = *(const f32x4*)(p.fnorm_w + 4 * lane + 256 * i);
            *(f32x4*)(p.out + O_Y + (size_t)tok * 1024 + 4 * lane + 256 * i) = (f32x4){v[i].x * rstd * ww.x, v[i].y * rstd * ww.y, v[i].z * rstd * ww.z, v[i].w * rstd * ww.w}; }
    }
}

__global__ void __launch_bounds__(512) hybrid_fwd(Params p) {
    extern __shared__ __attribute__((aligned(16))) unsigned char smem[];
    cg::grid_group grid = cg::this_grid();
    volatile LAS unsigned* xst = (volatile LAS unsigned*)((LAS unsigned char*)smem + SMEM_XB);
    if (threadIdx.x < 4) xst[threadIdx.x] = 0u;
    __syncthreads();
    const XcdBarrier xb = xcd_barrier_post((unsigned*)(p.ws + WS_BAR), xst);
#ifdef ONLY_PH
#define RUN(k) ((k) == ONLY_PH)
#define SYNC(k)
#else
#define RUN(k) (p.ph_lo <= (k) && (k) < p.ph_hi)
#define SYNC(k) if (p.ph_lo < (k) && (k) < p.ph_hi) { if (p.use_cg) grid.sync(); else { xcd_barrier(xb); if ((PROBE_MASK >> 17) & 1) xcd_barrier(xb); } }
#endif
    _Pragma("unroll") for (int rep = 0; rep <= ((PROBE_MASK >> 0) & 1); ++rep) if (RUN(0)) phase_prep(p, smem);
    SYNC(1);
    _Pragma("unroll") for (int rep = 0; rep <= ((PROBE_MASK >> 1) & 1); ++rep) if (RUN(1)) { pg8::Gemm g{(const bf16_t*)(p.ws + WS_XN), (const bf16_t*)(p.ws + WS_WTA), T_TOK, LDP0, 1024, 1024}; pg8::StaticOrder S; S.init(g.M, g.N, gridDim.x, blockIdx.x);
                  pg8::EpiBf16 E{(bf16_t*)(p.ws + WS_P0), LDP0}; pg8::gemm_phase((LAS unsigned char*)smem, g, S, E); }
    SYNC(2);
    _Pragma("unroll") for (int rep = 0; rep <= ((PROBE_MASK >> 2) & 1); ++rep) if (RUN(2)) phase_gdn_prep(p, smem);
    SYNC(3);
    _Pragma("unroll") for (int rep = 0; rep <= ((PROBE_MASK >> 3) & 1); ++rep) if (RUN(3)) phase_gdn_scan(p, smem);
    SYNC(4);
    _Pragma("unroll") for (int rep = 0; rep <= ((PROBE_MASK >> 4) & 1); ++rep) if (RUN(4)) phase_gdn_gate(p);
    SYNC(5);
    _Pragma("unroll") for (int rep = 0; rep <= ((PROBE_MASK >> 5) & 1); ++rep) if (RUN(5)) { pg8::Gemm g{(const bf16_t*)(p.ws + WS_OG), (const bf16_t*)(p.ws + WS_WTOA), T_TOK, 1024, 1024, 1024}; pg8::MainOrder S{(int)gridDim.x, (int)blockIdx.x};
                  pg8::EpiRes E{(float*)(p.ws + WS_X1), p.xp, p.xs, T_PR}; pg8::gemm_phase((LAS unsigned char*)smem, g, S, E);
                  pg8::Gemm gt{g.A, g.Bt, T_TOK, 1024, 256, 1024}; pg8::TailOrder St{(int)gridDim.x, (int)blockIdx.x, 4, 256};
                  pg8::EpiPart Et{(float*)(p.ws + WS_PART1)}; pg8::gemm_phase((LAS unsigned char*)smem, gt, St, Et); }
    SYNC(6);
    _Pragma("unroll") for (int rep = 0; rep <= ((PROBE_MASK >> 6) & 1); ++rep) if (RUN(6)) phase_norm1(p);
    SYNC(7);
    _Pragma("unroll") for (int rep = 0; rep <= ((PROBE_MASK >> 7) & 1); ++rep) if (RUN(7)) { pg8::Gemm g{(const bf16_t*)(p.ws + WS_XN), (const bf16_t*)(p.ws + WS_WTB), T_TOK, LDP1, 1024, 1024}; pg8::StaticOrder S; S.init(g.M, g.N, gridDim.x, blockIdx.x);
                  pg8::EpiBf16 E{(bf16_t*)(p.ws + WS_P1), LDP1}; pg8::gemm_phase((LAS unsigned char*)smem, g, S, E); }
    SYNC(8);
    _Pragma("unroll") for (int rep = 0; rep <= ((PROBE_MASK >> 8) & 1); ++rep) if (RUN(8)) phase_ret_prep(p, smem);
    SYNC(9);
    _Pragma("unroll") for (int rep = 0; rep <= ((PROBE_MASK >> 9) & 1); ++rep) if (RUN(9)) phase_ret_scan(p, smem);
    SYNC(10);
    _Pragma("unroll") for (int rep = 0; rep <= ((PROBE_MASK >> 10) & 1); ++rep) if (RUN(10)) phase_ret_gate(p);
    SYNC(11);
    _Pragma("unroll") for (int rep = 0; rep <= ((PROBE_MASK >> 11) & 1); ++rep) if (RUN(11)) { pg8::Gemm g{(const bf16_t*)(p.ws + WS_OG), (const bf16_t*)(p.ws + WS_WTOB), T_TOK, 1024, 2048, 2048}; pg8::MainOrder S{(int)gridDim.x, (int)blockIdx.x};
                   pg8::EpiRes E{(float*)(p.ws + WS_X2), (const float*)(p.ws + WS_X1), (const float*)(p.ws + WS_X1), T_TOK}; pg8::gemm_phase((LAS unsigned char*)smem, g, S, E);
                   pg8::Gemm gt{g.A, g.Bt, T_TOK, 1024, 256, 2048}; pg8::TailOrder St{(int)gridDim.x, (int)blockIdx.x, 8, 256};
                   pg8::EpiPart Et{(float*)(p.ws + WS_PART2)}; pg8::gemm_phase((LAS unsigned char*)smem, gt, St, Et); }
    SYNC(12);
    _Pragma("unroll") for (int rep = 0; rep <= ((PROBE_MASK >> 12) & 1); ++rep) if (RUN(12)) phase_final(p);
}

#ifndef N_LAUNCH_SPLIT
#define N_LAUNCH_SPLIT 0
#endif

extern "C" void kernel_launch(void* const* d_in, const int* in_sizes, int n_in, void* d_out, int out_size, void* d_ws, size_t ws_size, hipStream_t stream) {
    static int grid_blocks = 0;
    if (!grid_blocks) {
        hipFuncSetAttribute((const void*)hybrid_fwd, hipFuncAttributeMaxDynamicSharedMemorySize, (int)SMEM_BYTES);
        int dev = 0, cus = 0, per_cu = 0;
        hipGetDevice(&dev);
        hipDeviceGetAttribute(&cus, hipDeviceAttributeMultiprocessorCount, dev);
        hipOccupancyMaxActiveBlocksPerMultiprocessor(&per_cu, hybrid_fwd, 512, SMEM_BYTES);
        if (per_cu < 1) per_cu = 1;
        grid_blocks = cus * 1;
        if (grid_blocks < 72) { fprintf(stderr, "too few CUs: %d\n", grid_blocks); }
    }
    if (ws_size < WS_TOTAL) { fprintf(stderr, "workspace too small: %zu < %zu\n", ws_size, (size_t)WS_TOTAL); return; }
    hipMemsetAsync((unsigned char*)d_ws + WS_BAR, 0, 16384, stream);
    Params p{};
    p.xp = (const float*)d_in[0]; p.xs = (const float*)d_in[1]; p.st_gdn = (const float*)d_in[2]; p.st_conv = (const float*)d_in[3]; p.st_ret = (const float*)d_in[4];
    p.norm_w = (const float*)d_in[5]; p.w_in_a = (const float*)d_in[6]; p.conv_w = (const float*)d_in[7]; p.a_log = (const float*)d_in[8]; p.dt_bias = (const float*)d_in[9];
    p.onorm_a = (const float*)d_in[10]; p.w_out_a = (const float*)d_in[11]; p.w_in_b = (const float*)d_in[12]; p.onorm_b = (const float*)d_in[13]; p.w_out_b = (const float*)d_in[14];
    p.fnorm_w = (const float*)d_in[15];
    p.out = (float*)d_out; p.ws = (unsigned char*)d_ws;
#if N_LAUNCH_SPLIT
    for (int ph = 0; ph < NPH; ++ph) {
        p.ph_lo = ph; p.ph_hi = ph + 1;
        void* args[] = {&p};
        hipError_t e = hipLaunchCooperativeKernel((const void*)hybrid_fwd, dim3(grid_blocks), dim3(512), args, SMEM_BYTES, stream);
        if (e != hipSuccess) fprintf(stderr, "launch failed (phase %d): %s\n", ph, hipGetErrorString(e));
    }
#else
    p.ph_lo = 0; p.ph_hi = NPH;
    void* args[] = {&p};
    hipError_t e = hipLaunchCooperativeKernel((const void*)hybrid_fwd, dim3(grid_blocks), dim3(512), args, SMEM_BYTES, stream);
    if (e != hipSuccess) fprintf(stderr, "cooperative launch failed: %s (grid %d)\n", hipGetErrorString(e), grid_blocks);
#endif
}
```

```cpp
#include <hip/hip_runtime.h>
#include <hip/hip_cooperative_groups.h>
#include <cstdio>
namespace cg = cooperative_groups;

#define DI __device__ __forceinline__
#define LAS __attribute__((address_space(3)))
typedef unsigned short bf16_t;
typedef short bf16x8 __attribute__((ext_vector_type(8)));
typedef float f32x2 __attribute__((ext_vector_type(2)));
typedef float f32x4 __attribute__((ext_vector_type(4)));
typedef float f32x16 __attribute__((ext_vector_type(16)));
typedef unsigned u32x2 __attribute__((ext_vector_type(2)));
typedef unsigned u32x4 __attribute__((ext_vector_type(4)));
typedef __bf16 bf2_t __attribute__((ext_vector_type(2)));

constexpr int T_TOK = 17408, T_PR = 16384, DM = 1024;
constexpr int LDP0 = 4352, LDP1 = 6144;
constexpr int NPH = 13;
#ifndef PROBE_MASK
#define PROBE_MASK 0
#endif
constexpr size_t SMEM_BYTES = 153600;

constexpr size_t WS_WTA = 0;
constexpr size_t WS_WTOA = WS_WTA + (size_t)4352 * 1024 * 2;
constexpr size_t WS_WTB = WS_WTOA + (size_t)1024 * 1024 * 2;
constexpr size_t WS_WTOB = WS_WTB + (size_t)6144 * 1024 * 2;
constexpr size_t WS_XN = WS_WTOB + (size_t)1024 * 2048 * 2;
constexpr size_t WS_ORAW = WS_XN + (size_t)T_TOK * 1024 * 2;
constexpr size_t WS_OG = WS_ORAW + (size_t)T_TOK * 2048 * 2;
constexpr size_t WS_X1 = WS_OG + (size_t)T_TOK * 2048 * 2;
constexpr size_t WS_X2 = WS_X1 + (size_t)T_TOK * 1024 * 4;
constexpr size_t ROP_STRIDE = 139264;
constexpr size_t WS_ROP = WS_X2 + (size_t)T_TOK * 1024 * 4;
constexpr size_t WS_RA = WS_ROP + ROP_STRIDE * 1024;
constexpr size_t WS_P0 = WS_RA;
constexpr size_t GOP_STRIDE = 73984;
constexpr size_t WS_GOP = WS_P0 + (size_t)T_TOK * LDP0 * 2;
constexpr size_t WS_PART1 = WS_GOP;
constexpr size_t WS_PART2 = WS_ROP;
constexpr size_t WS_P1 = WS_RA;
constexpr size_t WS_END = WS_GOP + GOP_STRIDE * 2048;
static_assert((size_t)T_TOK * LDP1 * 2 <= WS_END - WS_RA, "P1 alias");
constexpr size_t WS_TABR = WS_END;
constexpr size_t WS_TABC = WS_TABR + 65536;
constexpr size_t WS_TABS = WS_TABC + 32768;
constexpr size_t WS_BAR = WS_TABS + 8192;
constexpr size_t WS_TOTAL = WS_BAR + 16384;
constexpr size_t SMEM_XB = 147456;

constexpr size_t O_Y = 0, O_GSP = 17825792, O_GCP = 18874368, O_RP = 18948096, O_GSS = 23142400, O_GCS = 39919616, O_RS = 41099264;

struct Params {
    const float *xp, *xs, *st_gdn, *st_conv, *st_ret, *norm_w, *w_in_a, *conv_w, *a_log, *dt_bias, *onorm_a, *w_out_a, *w_in_b, *onorm_b, *w_out_b, *fnorm_w;
    float* out;
    unsigned char* ws;
    int ph_lo, ph_hi;
    int use_cg, pad0;
};

DI unsigned pk_bf16(float a, float b) { f32x2 v = {a, b}; bf2_t r = __builtin_convertvector(v, bf2_t); return __builtin_bit_cast(unsigned, r); }
DI bf16_t f2bf(float a) { return (bf16_t)(pk_bf16(a, 0.f) & 0xffffu); }
DI float bf2f(bf16_t b) { return __uint_as_float(((unsigned)b) << 16); }
DI float bflo(unsigned u) { return __uint_as_float(u << 16); }
DI float bfhi(unsigned u) { return __uint_as_float(u & 0xffff0000u); }
DI float silu_f(float x) { return x * __builtin_amdgcn_rcpf(1.f + __expf(-x)); }
DI float row16_sum(float v) {
    v += __builtin_bit_cast(float, __builtin_amdgcn_update_dpp(0, __builtin_bit_cast(int, v), 0xB1, 0xF, 0xF, true));
    v += __builtin_bit_cast(float, __builtin_amdgcn_update_dpp(0, __builtin_bit_cast(int, v), 0x4E, 0xF, 0xF, true));
    v += __builtin_bit_cast(float, __builtin_amdgcn_update_dpp(0, __builtin_bit_cast(int, v), 0x124, 0xF, 0xF, true));
    v += __builtin_bit_cast(float, __builtin_amdgcn_update_dpp(0, __builtin_bit_cast(int, v), 0x128, 0xF, 0xF, true));
    return v;
}
DI float wave_sum(float v) {
    v = row16_sum(v);
    v += __shfl_xor(v, 16);
    v += __shfl_xor(v, 32);
    return v;
}
DI bf16x8 packB(const f32x16& x, const int s) {
    u32x4 p; p.x = pk_bf16(x[8 * s], x[8 * s + 1]); p.y = pk_bf16(x[8 * s + 2], x[8 * s + 3]); p.z = pk_bf16(x[8 * s + 4], x[8 * s + 5]); p.w = pk_bf16(x[8 * s + 6], x[8 * s + 7]);
    return __builtin_bit_cast(bf16x8, p);
}
DI bf16x8 ldA_perm(const bf16_t* rowp, int hh) {
    const u32x2 lo = *(const u32x2*)(rowp + 4 * hh), hi = *(const u32x2*)(rowp + 8 + 4 * hh);
    u32x4 v = {lo.x, lo.y, hi.x, hi.y}; return __builtin_bit_cast(bf16x8, v);
}
DI bf16x8 ld16(const bf16_t* p) { return __builtin_bit_cast(bf16x8, *(const u32x4*)p); }
#define MFMA32(a, b, c) __builtin_amdgcn_mfma_f32_32x32x16_bf16((a), (b), (c), 0, 0, 0)
DI void split2(float a, float b, unsigned& hi, unsigned& lo) { hi = pk_bf16(a, b); lo = pk_bf16(a - bflo(hi), b - bfhi(hi)); }
DI void split8(const f32x4& v0, const f32x4& v1, bf16x8& hi, bf16x8& lo) {
    unsigned h0, h1, h2, h3, l0, l1, l2, l3; split2(v0.x, v0.y, h0, l0); split2(v0.z, v0.w, h1, l1); split2(v1.x, v1.y, h2, l2); split2(v1.z, v1.w, h3, l3);
    const u32x4 h = {h0, h1, h2, h3}, l = {l0, l1, l2, l3};
    hi = __builtin_bit_cast(bf16x8, h); lo = __builtin_bit_cast(bf16x8, l);
}
DI void split4z(float a, float b, float c, float d, bf16x8& hi, bf16x8& lo) {
    unsigned h0, h1, l0, l1; split2(a, b, h0, l0); split2(c, d, h1, l1);
    const u32x4 h = {h0, h1, 0u, 0u}, l = {l0, l1, 0u, 0u};
    hi = __builtin_bit_cast(bf16x8, h); lo = __builtin_bit_cast(bf16x8, l);
}
DI int crow(int i, int hh) { return (i & 3) + 8 * (i >> 2) + 4 * hh; }
DI void lds_barrier() { asm volatile("s_waitcnt lgkmcnt(0)" ::: "memory"); __builtin_amdgcn_s_barrier(); asm volatile("" ::: "memory"); }
DI int opaque_tid() { int t = threadIdx.x; asm volatile("" : "+v"(t)); return t; }


#define XB_TMO      128
#define XB_XCNT(j)  (256  + 64 * (j))
#define XB_XSUB(j)  (1280 + 64 * (j))
#define XB_XGEN(j)  (2304 + 64 * (j))
#define XB_TOP      3328
#define XB_TOPGEN   3392
#define XCD_BAR_WORDS 3456
#define XB_SPIN_CAP (1u << 18)
DI unsigned xb_ld(unsigned* p) { return __hip_atomic_load(p, __ATOMIC_RELAXED, __HIP_MEMORY_SCOPE_AGENT); }
DI unsigned xb_add(unsigned* p, unsigned v) { return __hip_atomic_fetch_add(p, v, __ATOMIC_RELAXED, __HIP_MEMORY_SCOPE_AGENT); }
DI unsigned xb_xcc_id() { return (unsigned)__builtin_amdgcn_s_getreg((3 << 11) | 20) & 0xFu; }
#define XB_SPIN(cond, bar) do { unsigned _sp = 0; while (cond) { __builtin_amdgcn_s_sleep(1); \
    if ((++_sp & 255u) == 0u) { if (xb_ld(&(bar)[XB_TMO])) break; if (_sp > XB_SPIN_CAP) { atomicAdd(&(bar)[XB_TMO], 1u); break; } } } } while (0)
struct XcdBarrier { unsigned* bar; unsigned x; volatile LAS unsigned* st; };
DI XcdBarrier xcd_barrier_post(unsigned* bar, volatile LAS unsigned* st) {
    XcdBarrier b; b.bar = bar; b.x = xb_xcc_id(); b.st = st;
    if (threadIdx.x == 0) (void)xb_add(&bar[XB_XCNT(b.x)], 1u);
    return b;
}
DI void xcd_barrier_complete(unsigned* bar, unsigned x, unsigned& nloc, unsigned& nx) {
    const unsigned G = gridDim.x * gridDim.y * gridDim.z;
    unsigned sum, cnt, mine, sp = 0u;
    for (;;) {
        sum = 0u; cnt = 0u; mine = 0u;
#pragma unroll
        for (unsigned j = 0; j < 16; ++j) { const unsigned c = xb_ld(&bar[XB_XCNT(j)]); sum += c; cnt += (c > 0u) ? 1u : 0u; mine = (j == x) ? c : mine; }
        if (sum == G) break;
        __builtin_amdgcn_s_sleep(1);
        if ((++sp & 255u) == 0u) { if (xb_ld(&bar[XB_TMO])) break; if (sp > XB_SPIN_CAP) { atomicAdd(&bar[XB_TMO], 1u); break; } }
    }
    nloc = mine > 0u ? mine : 1u; nx = cnt > 0u ? cnt : 1u;
}
DI void xcd_barrier_slow(unsigned* bar, unsigned x, volatile LAS unsigned* st) {
    __builtin_amdgcn_s_waitcnt(0);
    unsigned nloc = st[0], nx = st[1];
    if (nloc == 0u) { xcd_barrier_complete(bar, x, nloc, nx); st[0] = nloc; st[1] = nx; }
    const unsigned old = xb_add(&bar[XB_XSUB(x)], 1u);
    const unsigned gen = old / nloc;
    if (old + 1u == (gen + 1u) * nloc) {
        __builtin_amdgcn_fence(__ATOMIC_RELEASE, "agent");
        asm volatile("s_waitcnt vmcnt(0)" ::: "memory");
        const unsigned og = xb_add(&bar[XB_TOP], 1u);
        const unsigned tg = og / nx;
        if (og + 1u == (tg + 1u) * nx) xb_add(&bar[XB_TOPGEN], 1u);
        else XB_SPIN(xb_ld(&bar[XB_TOPGEN]) == tg, bar);
        __builtin_amdgcn_fence(__ATOMIC_ACQUIRE, "agent");
        xb_add(&bar[XB_XGEN(x)], 1u);
        asm volatile("s_waitcnt vmcnt(0)" ::: "memory");
    } else {
        XB_SPIN(xb_ld(&bar[XB_XGEN(x)]) == gen, bar);
        __builtin_amdgcn_fence(__ATOMIC_ACQUIRE, "agent");
        asm volatile("s_waitcnt vmcnt(0)" ::: "memory");
    }
}
DI void xcd_barrier(const XcdBarrier& b) {
    asm volatile("s_waitcnt vmcnt(0)" ::: "memory");
    __syncthreads();
    if (threadIdx.x == 0) xcd_barrier_slow(b.bar, b.x, b.st);
    __syncthreads();
}

namespace pg8 {
constexpr int BM = 256, BK = 64, HALF = 128, HTB = HALF * BK * 2, STAGE_BYTES = 8 * HTB, NXCD = 8, WGM = 8;
DI int lds_byte(int r, int c) { const int st = (r >> 4) * 2 + (c >> 5), rr = r & 15, cc = c & 31, ob = rr * 64 + cc * 2; return st * 1024 + (ob ^ (((ob >> 9) & 1) << 5)); }
DI void stage_rc(int b, int& R, int& C) { const int st = b / 1024, sb = b % 1024, swz = sb ^ (((sb >> 9) & 1) << 5); R = (st >> 1) * 16 + swz / 64; C = (st & 1) * 32 + (swz % 64) / 2; }
DI int perm32(int rho) { const int n = rho >> 4, i = rho & 15; return 8 * (i >> 2) + 4 * n + (i & 3); }
struct Unit { int pm, pn, koff, slice; };
struct Gemm { const bf16_t* A; const bf16_t* Bt; int M, N, K, ld; };
struct StaticOrder {
    int nM, nN, nwg, G, c;
    DI void init(int M, int N, int G_, int c_) { nM = M / BM; nN = N / BM; nwg = nM * nN; G = G_; c = c_; }
    DI bool next(int i, Unit& u) const {
        const long L = (long)i * G + c; if (L >= nwg) return false;
        int wgid = (int)L; { const int q = nwg / NXCD, r = nwg % NXCD, xcd = wgid % NXCD, off = wgid / NXCD; wgid = (xcd < r ? xcd * (q + 1) : r * (q + 1) + (xcd - r) * q) + off; }
        const int nig = WGM * nN, gid = wgid / nig, fm = gid * WGM, gsz = (nM - fm) < WGM ? (nM - fm) : WGM;
        u.pm = fm + ((wgid % nig) % gsz); u.pn = (wgid % nig) / gsz; u.koff = 0; u.slice = 0; return true;
    }
};
struct MainOrder { int G, c; DI bool next(int i, Unit& u) const { const int L = i * G + c; if (L >= 256) return false; u.pm = L >> 2; u.pn = L & 3; u.koff = 0; u.slice = 0; return true; } };
struct TailOrder { int G, c, NS, klen; DI bool next(int i, Unit& u) const { const int L = i * G + c; if (L >= 16 * NS) return false; const int un = L / NS; u.slice = L - un * NS; u.pm = 64 + (un >> 2); u.pn = un & 3; u.koff = u.slice * klen; return true; } };
struct EpiBf16 {
    static constexpr bool PERM = true;
    bf16_t* O; int ldc;
    DI void operator()(const f32x4 (&acc)[2][2][4][2], const Unit& u, int wr, int wc, int fr, int fq) const {
        const int row0 = u.pm * BM + wr * 64 + fr, col0 = u.pn * BM + wc * 32 + 8 * fq;
#pragma unroll
        for (int ai = 0; ai < 2; ++ai)
#pragma unroll
            for (int m = 0; m < 4; ++m) { bf16_t* rowp = O + (size_t)(row0 + ai * HALF + m * 16) * ldc + col0;
#pragma unroll
                for (int bj = 0; bj < 2; ++bj) { const f32x4 v0 = acc[ai][bj][m][0], v1 = acc[ai][bj][m][1];
                    u32x4 w; w.x = pk_bf16(v0[0], v0[1]); w.y = pk_bf16(v0[2], v0[3]); w.z = pk_bf16(v1[0], v1[1]); w.w = pk_bf16(v1[2], v1[3]);
                    *(u32x4*)(rowp + bj * HALF) = w; } }
    }
};
struct EpiRes {
    static constexpr bool PERM = false;
    float* O; const float* resA; const float* resB; int split;
    DI void operator()(const f32x4 (&acc)[2][2][4][2], const Unit& u, int wr, int wc, int fr, int fq) const {
        const int row0 = u.pm * BM + wr * 64 + fr, col0 = u.pn * BM + wc * 32 + 4 * fq;
#pragma unroll
        for (int ai = 0; ai < 2; ++ai)
#pragma unroll
            for (int m = 0; m < 4; ++m) { const int r = row0 + ai * HALF + m * 16;
                const float* rp = (r < split ? resA + (size_t)r * 1024 : resB + (size_t)(r - split) * 1024) + col0; float* op = O + (size_t)r * 1024 + col0;
#pragma unroll
                for (int bj = 0; bj < 2; ++bj)
#pragma unroll
                    for (int n = 0; n < 2; ++n) *(f32x4*)(op + bj * HALF + n * 16) = acc[ai][bj][m][n] + *(const f32x4*)(rp + bj * HALF + n * 16); }
    }
};

struct EpiPart {
    static constexpr bool PERM = false;
    float* P;
    DI void operator()(const f32x4 (&acc)[2][2][4][2], const Unit& u, int wr, int wc, int fr, int fq) const {
        const int row0 = (u.pm - 64) * BM + wr * 64 + fr, col0 = u.pn * BM + wc * 32 + 4 * fq;
        float* base = P + (size_t)u.slice * 1048576;
#pragma unroll
        for (int ai = 0; ai < 2; ++ai)
#pragma unroll
            for (int m = 0; m < 4; ++m) { float* op = base + (size_t)(row0 + ai * HALF + m * 16) * 1024 + col0;
#pragma unroll
                for (int bj = 0; bj < 2; ++bj)
#pragma unroll
                    for (int n = 0; n < 2; ++n) *(f32x4*)(op + bj * HALF + n * 16) = acc[ai][bj][m][n]; }
    }
};

template <class Epi, class Sched>
DI void gemm_phase(LAS unsigned char* lds, const Gemm g, const Sched& S, const Epi& E) {
    const int tid = opaque_tid(), wid = __builtin_amdgcn_readfirstlane(tid >> 6), lane = tid & 63, wr = wid >> 2, wc = wid & 3, fr = lane & 15, fq = lane >> 4;
    const int K = g.ld, nt = g.K / BK;
    unsigned voffA[2], voffB[2];
#pragma unroll
    for (int i = 0; i < 2; ++i) { int R, C; stage_rc(tid * 16 + i * 8192, R, C); const int Rb = Epi::PERM ? ((R & ~31) + perm32(R & 31)) : R;
        voffA[i] = (unsigned)(R * K + C) * 2u; voffB[i] = (unsigned)(Rb * K + C) * 2u; }
    const size_t kstep = (size_t)(BK * 2);
    const size_t hstep = (size_t)HALF * K * 2;
    const size_t tstep = 2 * hstep;
    const unsigned ldsw = (unsigned)wid * 1024u;
    const int aoff = lds_byte(wr * 64 + fr, fq * 8), boff = lds_byte(wc * 32 + fr, fq * 8);
#define PG8_SA(b, h) (((b) * 2 + (h)) * HTB)
#define PG8_SB(b, h) ((4 + (b) * 2 + (h)) * HTB)
#define PG8_STAGE(bufoff, gbase, voff) do { _Pragma("unroll") for (int _i = 0; _i < 2; ++_i) \
        __builtin_amdgcn_global_load_lds((const unsigned*)((const char*)(gbase) + (voff)[_i]), (LAS unsigned*)(lds + (bufoff) + ldsw + _i * 8192), 16, 0, 0); } while (0)
#define PG8_LDA(dst, b, h) do { _Pragma("unroll") for (int m = 0; m < 4; ++m) _Pragma("unroll") for (int k = 0; k < 2; ++k) dst[m][k] = *(const LAS bf16x8*)(lds + PG8_SA(b, h) + aoff + m * 2048 + k * 1024); } while (0)
#define PG8_LDB(dst, b, h) do { _Pragma("unroll") for (int n = 0; n < 2; ++n) _Pragma("unroll") for (int k = 0; k < 2; ++k) dst[n][k] = *(const LAS bf16x8*)(lds + PG8_SB(b, h) + boff + n * 2048 + k * 1024); } while (0)
#define PG8_MMA(ai, bj, At, Bt) do { __builtin_amdgcn_s_setprio(1); _Pragma("unroll") for (int m = 0; m < 4; ++m) _Pragma("unroll") for (int n = 0; n < 2; ++n) _Pragma("unroll") for (int k = 0; k < 2; ++k) \
        acc[ai][bj][m][n] = __builtin_amdgcn_mfma_f32_16x16x32_bf16(Bt[n][k], At[m][k], acc[ai][bj][m][n], 0, 0, 0); __builtin_amdgcn_s_setprio(0); } while (0)
#define PG8_WAIT_V(n) asm volatile("s_waitcnt vmcnt(" #n ")" ::: "memory")
#define PG8_WAIT_L(n) asm volatile("s_waitcnt lgkmcnt(" #n ")" ::: "memory")
#define PG8_BAR __builtin_amdgcn_s_barrier()
#define PG8_SCHED __builtin_amdgcn_sched_barrier(0)
    Unit cur, nxt; int ui = 0;
    if (!S.next(0, cur)) return;
    f32x4 acc[2][2][4][2];
#pragma unroll
    for (int a = 0; a < 2; ++a)
#pragma unroll
        for (int b = 0; b < 2; ++b)
#pragma unroll
            for (int m = 0; m < 4; ++m)
#pragma unroll
                for (int n = 0; n < 2; ++n) acc[a][b][m][n] = (f32x4){0.f, 0.f, 0.f, 0.f};
    bf16x8 At[4][2], B0[2][2], B1[2][2];
    const char* cA = (const char*)g.A + (size_t)cur.pm * tstep + (size_t)cur.koff * 2; const char* cB = (const char*)g.Bt + (size_t)cur.pn * tstep + (size_t)cur.koff * 2;
    PG8_STAGE(PG8_SB(0, 0), cB, voffB); PG8_STAGE(PG8_SA(0, 0), cA, voffA); PG8_STAGE(PG8_SB(0, 1), cB + hstep, voffB); PG8_STAGE(PG8_SA(0, 1), cA + hstep, voffA);
    if (wr == 1) PG8_BAR;
    PG8_WAIT_V(4); PG8_BAR;
    PG8_STAGE(PG8_SB(1, 0), cB + kstep, voffB); PG8_STAGE(PG8_SA(1, 0), cA + kstep, voffA); PG8_STAGE(PG8_SB(1, 1), cB + hstep + kstep, voffB);
    PG8_WAIT_V(6); PG8_BAR;
    for (;;) {
        const bool has_next = S.next(ui + 1, nxt);
        const char* nA = has_next ? (const char*)g.A + (size_t)nxt.pm * tstep + (size_t)nxt.koff * 2 : cA; const char* nB = has_next ? (const char*)g.Bt + (size_t)nxt.pn * tstep + (size_t)nxt.koff * 2 : cB;
        for (int t = 0; t < nt; t += 2) {
            const bool last = (t == nt - 2);
            const char* a1 = cA + (size_t)(t + 1) * kstep;
            const char* a2 = last ? nA : cA + (size_t)(t + 2) * kstep; const char* b2 = last ? nB : cB + (size_t)(t + 2) * kstep;
            const char* a3 = a2 + kstep; const char* b3 = b2 + kstep;
            PG8_LDB(B0, 0, 0); PG8_SCHED; PG8_LDA(At, 0, 0); PG8_STAGE(PG8_SA(1, 1), a1 + hstep, voffA);
            PG8_WAIT_L(8); PG8_BAR; PG8_WAIT_L(0); PG8_MMA(0, 0, At, B0); PG8_BAR; PG8_SCHED;
            PG8_LDB(B1, 0, 1); PG8_STAGE(PG8_SB(0, 0), b2, voffB);
            PG8_BAR; PG8_WAIT_L(0); PG8_MMA(0, 1, At, B1); PG8_BAR;
            PG8_LDA(At, 0, 1); PG8_STAGE(PG8_SA(0, 0), a2, voffA);
            PG8_BAR; PG8_WAIT_L(0); PG8_MMA(1, 0, At, B0); PG8_BAR; PG8_SCHED;
            PG8_STAGE(PG8_SB(0, 1), b2 + hstep, voffB);
            PG8_WAIT_V(6); PG8_BAR; PG8_MMA(1, 1, At, B1); PG8_BAR;
            PG8_LDB(B0, 1, 0); PG8_SCHED; PG8_LDA(At, 1, 0); PG8_STAGE(PG8_SA(0, 1), a2 + hstep, voffA);
            PG8_WAIT_L(8); PG8_BAR; PG8_WAIT_L(0); PG8_MMA(0, 0, At, B0); PG8_BAR; PG8_SCHED;
            PG8_LDB(B1, 1, 1); PG8_STAGE(PG8_SB(1, 0), b3, voffB);
            PG8_BAR; PG8_WAIT_L(0); PG8_MMA(0, 1, At, B1); PG8_BAR;
            PG8_LDA(At, 1, 1); PG8_STAGE(PG8_SA(1, 0), a3, voffA);
            PG8_BAR; PG8_WAIT_L(0); PG8_MMA(1, 0, At, B0); PG8_BAR; PG8_SCHED;
            PG8_STAGE(PG8_SB(1, 1), b3 + hstep, voffB);
            PG8_WAIT_V(6); PG8_BAR; PG8_MMA(1, 1, At, B1); PG8_BAR;
        }
        E(acc, cur, wr, wc, fr, fq);
        if (!has_next) break;
#pragma unroll
        for (int a = 0; a < 2; ++a)
#pragma unroll
            for (int b = 0; b < 2; ++b)
#pragma unroll
                for (int m = 0; m < 4; ++m)
#pragma unroll
                    for (int n = 0; n < 2; ++n) acc[a][b][m][n] = (f32x4){0.f, 0.f, 0.f, 0.f};
        cur = nxt; cA = nA; cB = nB; ++ui;
    }
    PG8_WAIT_V(0);
    if (wr == 0) PG8_BAR;
    PG8_BAR;
#undef PG8_SA
#undef PG8_SB
#undef PG8_STAGE
#undef PG8_LDA
#undef PG8_LDB
#undef PG8_MMA
#undef PG8_WAIT_V
#undef PG8_WAIT_L
#undef PG8_BAR
#undef PG8_SCHED
}
}

DI void transpose_tile(const float* W, int ldw, int nvalid, int k0, int n0, bf16_t* Wt, int ldt, float* tile  ) {
    const int tid = threadIdx.x;
#pragma unroll
    for (int m = 0; m < 8; ++m) { const int e = tid + 512 * m, kk = e >> 6, nn = e & 63;
        tile[kk * 65 + nn] = (n0 + nn < nvalid) ? W[(size_t)(k0 + kk) * ldw + n0 + nn] : 0.f; }
    lds_barrier();
    { const int nn = tid >> 3, kq = tid & 7; float v[8];
#pragma unroll
      for (int j = 0; j < 8; ++j) v[j] = tile[(kq * 8 + j) * 65 + nn];
      u32x4 w; w.x = pk_bf16(v[0], v[1]); w.y = pk_bf16(v[2], v[3]); w.z = pk_bf16(v[4], v[5]); w.w = pk_bf16(v[6], v[7]);
      *(u32x4*)(Wt + (size_t)(n0 + nn) * ldt + k0 + kq * 8) = w; }
    lds_barrier();
}
DI void rmsnorm_bf16(const float* srcA, const float* srcB, int split, const float* w, bf16_t* out) {
    const int lane = threadIdx.x & 63, gw = blockIdx.x * 8 + (threadIdx.x >> 6), nw = gridDim.x * 8;
    for (int tok = gw; tok < T_TOK; tok += nw) {
        const float* src = tok < split ? srcA + (size_t)tok * 1024 : srcB + (size_t)(tok - split) * 1024;
        f32x4 v[4]; float ss = 0.f;
#pragma unroll
        for (int i = 0; i < 4; ++i) { v[i] = *(const f32x4*)(src + 4 * lane + 256 * i); ss += v[i].x * v[i].x + v[i].y * v[i].y + v[i].z * v[i].z + v[i].w * v[i].w; }
        ss = wave_sum(ss);
        const float rstd = rsqrtf(ss * (1.f / 1024.f) + 1e-6f);
#pragma unroll
        for (int i = 0; i < 4; ++i) { const f32x4 ww = *(const f32x4*)(w + 4 * lane + 256 * i);
            u32x2 o; o.x = pk_bf16(v[i].x * rstd * ww.x, v[i].y * rstd * ww.y); o.y = pk_bf16(v[i].z * rstd * ww.z, v[i].w * rstd * ww.w);
            *(u32x2*)(out + (size_t)tok * 1024 + 4 * lane + 256 * i) = o; }
    }
}
DI void phase_prep(const Params& p, unsigned char* smem) {
    float* tile = (float*)smem;
    bf16_t* wta = (bf16_t*)(p.ws + WS_WTA); bf16_t* wtoa = (bf16_t*)(p.ws + WS_WTOA); bf16_t* wtb = (bf16_t*)(p.ws + WS_WTB); bf16_t* wtob = (bf16_t*)(p.ws + WS_WTOB);
    for (int t = blockIdx.x; t < 3392; t += gridDim.x) {
        if (t < 1088) transpose_tile(p.w_in_a, 4112, 4112, (t & 15) * 64, (t >> 4) * 64, wta, 1024, tile);
        else if (t < 1344) { const int u = t - 1088; transpose_tile(p.w_out_a, 1024, 1024, (u & 15) * 64, (u >> 4) * 64, wtoa, 1024, tile); }
        else if (t < 2880) { const int u = t - 1344; transpose_tile(p.w_in_b, 6144, 6144, (u & 15) * 64, (u >> 4) * 64, wtb, 1024, tile); }
        else { const int u = t - 2880; transpose_tile(p.w_out_b, 1024, 1024, (u & 31) * 64, (u >> 5) * 64, wtob, 2048, tile); }
    }
    rmsnorm_bf16(p.xp, p.xs, T_PR, p.norm_w, (bf16_t*)(p.ws + WS_XN));
    for (int e = blockIdx.x * 512 + threadIdx.x; e < (64 + 32 + 8) * 128; e += gridDim.x * 512) {
        const int i = e & 127, r = e >> 7;
        const double inv = exp(-((double)i / 127.0) * 9.210340371976184);
        const double pos = r < 64 ? (double)r : r < 96 ? (double)((r - 64) * 64) : (double)(16384 + (r - 96));
        double sn, cs; sincos(pos * inv, &sn, &cs);
        f32x2* dst = (f32x2*)(p.ws + (r < 64 ? WS_TABR : r < 96 ? WS_TABC : WS_TABS)) + ((r < 64 ? r : r < 96 ? r - 64 : r - 96) * 128 + i);
        *dst = (f32x2){(float)cs, (float)sn};
    }
}

DI void phase_gdn_prep(const Params& p, unsigned char* smem) {
    float* ks = (float*)smem;
    float* vs = ks + 64 * 132;
    float* lowT = vs + 64 * 132;
    float* Gs = lowT + 64 * 68;
    float* Bs = Gs + 64;
    float* Es = Bs + 64;
    float* qs = Es + 64 + 64;
    float* solL = qs;
    const bf16_t* P0 = (const bf16_t*)(p.ws + WS_P0);
    const int tid = opaque_tid(), lane = tid & 63, wid = tid >> 6, hh = lane >> 5, l31 = lane & 31;
    for (int e = blockIdx.x * 512 + tid; e < (8 + 128) * 3 * 3072; e += gridDim.x * 512) {
        const int ch = e % 3072, r = (e / 3072) % 3, b = e / 9216;
        if (b < 8) p.out[O_GCP + (size_t)(b * 3 + r) * 3072 + ch] = bf2f(P0[(size_t)(b * 2048 + 2045 + r) * LDP0 + ch]);
        else { const int bb = b - 8; p.out[O_GCS + (size_t)(bb * 3 + r) * 3072 + ch] = bf2f(P0[(size_t)(T_PR + bb * 8 + 5 + r) * LDP0 + ch]); }
    }
    const int a_rg = tid / 96, a_cq = tid - a_rg * 96, a_sec = a_cq >> 5, a_c4 = (a_cq & 31) * 4, a_r0 = a_rg * 13;
    u32x2 xv[16];
#define GDN_LOAD_ROWS(it) do { const int n_ = (it) & 31, h_ = ((it) >> 5) & 7, b_ = (it) >> 8, col_ = a_sec * 1024 + h_ * 128 + a_c4; \
        _Pragma("unroll") for (int r = 0; r < 16; ++r) { const int rr = a_r0 + r - 3, tr = n_ * 64 + rr; \
            xv[r] = (a_rg < 5 && rr < 64 && tr >= 0) ? *(const u32x2*)(P0 + (size_t)(b_ * 2048 + tr) * LDP0 + col_) : (u32x2){0u, 0u}; } } while (0)
    if ((int)blockIdx.x < 2048) GDN_LOAD_ROWS((int)blockIdx.x);
    for (int item = blockIdx.x; item < 2048; item += gridDim.x) {
        const int n = item & 31, h = (item >> 5) & 7, b = item >> 8;
        const int tok0 = b * 2048 + n * 64;
        unsigned char* blk = p.ws + WS_GOP + (size_t)item * GOP_STRIDE;
        int tid_i = tid; asm volatile("" : "+v"(tid_i));
        const int tid = tid_i, lane = tid & 63, wid = tid >> 6, hh = lane >> 5, l31 = lane & 31;
        float braw = 0.f, araw = 0.f;
        if (wid == 0) { braw = bf2f(P0[(size_t)(tok0 + lane) * LDP0 + 4096 + h]); araw = bf2f(P0[(size_t)(tok0 + lane) * LDP0 + 4104 + h]); }
        bf16_t* o_nw = (bf16_t*)blk; bf16_t* o_qe = o_nw + 8192; bf16_t* o_kdT = o_qe + 8192; bf16_t* o_qkd = o_kdT + 8192; bf16_t* o_u0T = o_qkd + 4096;
        _Pragma("unroll") for (int rpA = 0; rpA <= ((PROBE_MASK >> 19) & 1); ++rpA)
        {
            const int rg = a_rg, sec = a_sec, c4 = a_c4, col = sec * 1024 + h * 128 + c4, r0 = a_r0;
            f32x4 w[4];
#pragma unroll
            for (int j = 0; j < 4; ++j) w[j] = *(const f32x4*)(p.conv_w + j * 3072 + col);
            float* dstb = (sec == 0 ? qs : sec == 1 ? ks : vs) + c4;
#pragma unroll
            for (int r = 0; r < 13; ++r) {
                float o0 = 0.f, o1 = 0.f, o2 = 0.f, o3 = 0.f;
#pragma unroll
                for (int j = 0; j < 4; ++j) { o0 += bflo(xv[r + j].x) * w[j].x; o1 += bfhi(xv[r + j].x) * w[j].y; o2 += bflo(xv[r + j].y) * w[j].z; o3 += bfhi(xv[r + j].y) * w[j].w; }
                o0 = silu_f(o0); o1 = silu_f(o1); o2 = silu_f(o2); o3 = silu_f(o3);
                float ss = row16_sum(o0 * o0 + o1 * o1 + o2 * o2 + o3 * o3);
                ss += __shfl_xor(ss, 16);
                float sc = 1.f;
                if (sec < 2) sc = rsqrtf(ss + 1e-6f) * (sec == 0 ? 0.08838834764831845f : 1.f);
                if (rg < 5 && r0 + r < 64) *(f32x4*)(dstb + (r0 + r) * 132) = (f32x4){o0 * sc, o1 * sc, o2 * sc, o3 * sc};
            }
        }
        if (wid == 0) {
            const float beta = 1.f / (1.f + expf(-braw));
            const float xx = araw + p.dt_bias[h];
            const float sp = xx > 20.f ? xx : log1pf(expf(xx));
            float g = -expf(p.a_log[h]) * sp;
#pragma unroll
            for (int d = 1; d < 64; d <<= 1) { const float t = __shfl_up(g, d); if (lane >= d) g += t; }
            Gs[lane] = g; Bs[lane] = beta; Es[lane] = expf(g);
        }
        lds_barrier();
        _Pragma("unroll") for (int rpC = 0; rpC <= ((PROBE_MASK >> 20) & 1); ++rpC) {
            const int which = wid >> 2, ti = (wid >> 1) & 1, tj = wid & 1;
            const float* Ap = (which ? qs : ks) + (32 * ti + l31) * 132 + 8 * hh;
            const float* Bp = ks + (32 * tj + l31) * 132 + 8 * hh;
            f32x16 acc;
#pragma unroll
            for (int i = 0; i < 16; ++i) acc[i] = 0.f;
            if (ti >= tj) {
#pragma unroll 2
                for (int k0 = 0; k0 < 128; k0 += 16) {
                    bf16x8 ah, al, bh, bl;
                    split8(*(const f32x4*)(Ap + k0), *(const f32x4*)(Ap + k0 + 4), ah, al);
                    split8(*(const f32x4*)(Bp + k0), *(const f32x4*)(Bp + k0 + 4), bh, bl);
                    acc = MFMA32(ah, bh, acc);
                    if (which == 0) { acc = MFMA32(ah, bl, acc); acc = MFMA32(al, bh, acc); }
                }
            }
            const int col = 32 * tj + l31; const float Gc = Gs[col];
#pragma unroll
            for (int i = 0; i < 16; ++i) {
                const int row = 32 * ti + crow(i, hh);
                const float dec = __expf(fminf(Gs[row] - Gc, 0.f));
                if (which == 0) lowT[col * 68 + row] = row > col ? Bs[row] * acc[i] * dec : 0.f;
                else { const int kk = col & 15; o_qkd[((((row >> 5) * 4 + (col >> 4)) * 64 + (row & 31) + 32 * ((kk >> 2) & 1)) << 3) + (kk & 3) + 4 * (kk >> 3)] = f2bf(row >= col ? acc[i] * dec : 0.f); }
            }
        }
        lds_barrier();
#pragma unroll
        for (int m = 0; m < 2; ++m) { const int e = tid + 512 * m, i = e >> 4, d0 = (e & 15) * 8; const float eg = Es[i]; const float* s = qs + i * 132 + d0;
            u32x2 w0, w1; w0.x = pk_bf16(s[0] * eg, s[1] * eg); w0.y = pk_bf16(s[2] * eg, s[3] * eg); w1.x = pk_bf16(s[4] * eg, s[5] * eg); w1.y = pk_bf16(s[6] * eg, s[7] * eg);
            bf16_t* fp = o_qe + ((((i >> 5) * 8 + (d0 >> 4)) * 64 + (i & 31)) << 3) + ((d0 >> 3) & 1) * 4;
            *(u32x2*)fp = w0; *(u32x2*)(fp + 32 * 8) = w1; }
        { const float GL = Gs[63];
#pragma unroll
          for (int m = 0; m < 2; ++m) { const int e = tid + 512 * m, d = e & 127, i0 = (e >> 7) * 8; float v[8];
#pragma unroll
            for (int j = 0; j < 8; ++j) v[j] = ks[(i0 + j) * 132 + d] * __expf(GL - Gs[i0 + j]);
            u32x2 w0, w1; w0.x = pk_bf16(v[0], v[1]); w0.y = pk_bf16(v[2], v[3]); w1.x = pk_bf16(v[4], v[5]); w1.y = pk_bf16(v[6], v[7]);
            bf16_t* fp = o_kdT + ((((d >> 5) * 4 + (i0 >> 4)) * 64 + (d & 31)) << 3) + ((i0 >> 3) & 1) * 4;
            *(u32x2*)fp = w0; *(u32x2*)(fp + 32 * 8) = w1; }
          if (tid == 0) *(float*)(blk + 73728) = expf(GL); }
        if (item + (int)gridDim.x < 2048) GDN_LOAD_ROWS(item + (int)gridDim.x);
        lds_barrier();
        _Pragma("unroll") for (int rpE = 0; rpE <= ((PROBE_MASK >> 18) & 1); ++rpE)
        {
            const int isk = wid >> 2, sl = wid & 3, c0 = sl * 32 + l31;
            const float* src = (isk ? ks : vs) + c0;
            f32x16 R[2];
#pragma unroll
            for (int rt = 0; rt < 2; ++rt)
#pragma unroll
                for (int i = 0; i < 16; ++i) { const int row = 32 * rt + crow(i, hh); R[rt][i] = Bs[row] * src[row * 132] * (isk ? Es[row] : 1.f); }
#pragma unroll
            for (int bI = 0; bI < 8; ++bI) {
                const int rt = bI >> 2, g = bI & 3;
                const int rA = 8 * bI + 4 * hh, rP = 8 * bI + 4 * (1 - hh);
                const float* tp = lowT + rA * 68 + rA;
                const float t10 = tp[1], t20 = tp[2], t30 = tp[3], t21 = tp[68 + 2], t31 = tp[68 + 3], t32 = tp[136 + 3];
                float a0 = R[rt][4 * g], a1 = R[rt][4 * g + 1], a2 = R[rt][4 * g + 2], a3 = R[rt][4 * g + 3];
                float x0 = a0, x1 = a1 - t10 * x0, x2 = a2 - t20 * x0 - t21 * x1, x3 = a3 - t30 * x0 - t31 * x1 - t32 * x2;
                const float y0 = __shfl_xor(x0, 32), y1 = __shfl_xor(x1, 32), y2 = __shfl_xor(x2, 32), y3 = __shfl_xor(x3, 32);
                const float* cq = lowT + rP * 68 + rA;
                a0 -= cq[0] * y0 + cq[68] * y1 + cq[136] * y2 + cq[204] * y3;
                a1 -= cq[1] * y0 + cq[68 + 1] * y1 + cq[136 + 1] * y2 + cq[204 + 1] * y3;
                a2 -= cq[2] * y0 + cq[68 + 2] * y1 + cq[136 + 2] * y2 + cq[204 + 2] * y3;
                a3 -= cq[3] * y0 + cq[68 + 3] * y1 + cq[136 + 3] * y2 + cq[204 + 3] * y3;
                x0 = a0; x1 = a1 - t10 * x0; x2 = a2 - t20 * x0 - t21 * x1; x3 = a3 - t30 * x0 - t31 * x1 - t32 * x2;
                if (isk) {
                    const int kk = c0 & 15; const float xs4[4] = {x0, x1, x2, x3};
#pragma unroll
                    for (int a = 0; a < 4; ++a) { const int row = rA + a;
                        o_nw[((((row >> 5) * 8 + (c0 >> 4)) * 64 + (row & 31) + 32 * ((kk >> 2) & 1)) << 3) + (kk & 3) + 4 * (kk >> 3)] = f2bf(-xs4[a]); }
                } else {
                    u32x2 w0; w0.x = pk_bf16(x0, x1); w0.y = pk_bf16(x2, x3);
                    *(u32x2*)(o_u0T + ((((sl * 2 + rt) * 64 + lane) << 4) + 4 * g)) = w0;
                }
                bf16x8 xh, xl; split4z(-x0, -x1, -x2, -x3, xh, xl);
#pragma unroll
                for (int rt2 = rt; rt2 < 2; ++rt2) {
                    if (rt2 == rt && g == 3) continue;
                    const float* ap = lowT + rA * 68 + 32 * rt2 + l31;
                    bf16x8 ah, al; split4z(ap[0], ap[68], ap[136], ap[204], ah, al);
                    R[rt2] = MFMA32(ah, xh, R[rt2]); R[rt2] = MFMA32(ah, xl, R[rt2]); R[rt2] = MFMA32(al, xh, R[rt2]);
                }
                __builtin_amdgcn_sched_barrier(0);
            }
        }
        lds_barrier();
    }
}

#define LDSV(off) (*(const LAS bf16x8*)(base + (off)))
DI void gdn_scan_prompt(const Params& p, int bh, unsigned char* smem) {
    LAS unsigned char* lds = (LAS unsigned char*)smem;
    const int tid = opaque_tid(), lane = tid & 63, wid = __builtin_amdgcn_readfirstlane(tid >> 6), hh = lane >> 5, l31 = lane & 31;
    const int h = bh & 7, b = bh >> 3, s = wid;
    const unsigned char* gblk = p.ws + WS_GOP + (size_t)bh * 32 * GOP_STRIDE;
    bf16_t* oraw = (bf16_t*)(p.ws + WS_ORAW);
    f32x16 S[4];
#pragma unroll
    for (int t = 0; t < 4; ++t)
#pragma unroll
        for (int i = 0; i < 16; ++i) S[t][i] = 0.f;
    unsigned voff16 = lane * 16; asm volatile("" : "+v"(voff16));
#define GDN_DMA(n, buf) do { const unsigned char* g_ = gblk + (size_t)(n) * GOP_STRIDE; _Pragma("unroll") for (int i_ = 0; i_ < 18; ++i_) { const int pc_ = (wid - 4) + 4 * i_; \
        __builtin_amdgcn_global_load_lds((const unsigned*)((g_ + pc_ * 1024) + voff16), (LAS unsigned*)(lds + (buf) * 73728 + pc_ * 1024), 16, 0, 0); } } while (0)
#define GDN_BAR() do { asm volatile("" ::: "memory"); __builtin_amdgcn_s_barrier(); asm volatile("" ::: "memory"); } while (0)
    lds_barrier();
#define GDN_PF(n) do { const unsigned char* g_ = gblk + (size_t)(n) * GOP_STRIDE; _Pragma("unroll") for (int i_ = 0; i_ < 18; ++i_) { const int pc_ = (wid - 4) + 4 * i_; \
        __builtin_amdgcn_global_load_lds((const unsigned*)((g_ + pc_ * 1024) + voff16), (LAS unsigned*)(lds + 148480 + (wid - 4) * 1024), 16, 0, 0); } } while (0)
    if (wid >= 4) { GDN_DMA(0, 0); GDN_PF(1); GDN_PF(2); asm volatile("s_waitcnt vmcnt(0)" ::: "memory"); }
    GDN_BAR();
    for (int n = 0; n < 32; ++n) {
        if (wid >= 4 && n + 1 < 32) GDN_DMA(n + 1, (n + 1) & 1);
        if (wid >= 4 && n + 3 < 32) GDN_PF(n + 3);
        if (wid < 4) {
            LAS unsigned char* base = lds + (n & 1) * 73728 + lane * 16;
            const float dl = *(const float*)(gblk + (size_t)n * GOP_STRIDE + 73728);
            bf16x8 Ub[4];
            {
                f32x16 U[2];
#pragma unroll
                for (int rt = 0; rt < 2; ++rt) {
#pragma unroll
                    for (int g = 0; g < 2; ++g) { const u32x4 v = *(const LAS u32x4*)(lds + (n & 1) * 73728 + 57344 + (((s * 2 + rt) * 64 + lane) << 5) + 16 * g);
                        U[rt][8 * g] = bflo(v.x); U[rt][8 * g + 1] = bfhi(v.x); U[rt][8 * g + 2] = bflo(v.y); U[rt][8 * g + 3] = bfhi(v.y);
                        U[rt][8 * g + 4] = bflo(v.z); U[rt][8 * g + 5] = bfhi(v.z); U[rt][8 * g + 6] = bflo(v.w); U[rt][8 * g + 7] = bfhi(v.w); }
                }
#pragma unroll
                for (int t = 0; t < 4; ++t)
#pragma unroll
                    for (int s2 = 0; s2 < 2; ++s2) {
                        const bf16x8 sb = packB(S[t], s2);
#pragma unroll
                        for (int rt = 0; rt < 2; ++rt) U[rt] = MFMA32(LDSV((rt * 8 + 2 * t + s2) * 1024), sb, U[rt]);
                    }
#pragma unroll
                for (int kc = 0; kc < 4; ++kc) Ub[kc] = packB(U[kc >> 1], kc & 1);
            }
            f32x16 O[2];
#pragma unroll
            for (int rt = 0; rt < 2; ++rt)
#pragma unroll
                for (int i = 0; i < 16; ++i) O[rt][i] = 0.f;
#pragma unroll
            for (int t = 0; t < 4; ++t)
#pragma unroll
                for (int s2 = 0; s2 < 2; ++s2) {
                    const bf16x8 sb = packB(S[t], s2);
#pragma unroll
                    for (int rt = 0; rt < 2; ++rt) O[rt] = MFMA32(LDSV(16384 + (rt * 8 + 2 * t + s2) * 1024), sb, O[rt]);
                }
#pragma unroll
            for (int rt = 0; rt < 2; ++rt)
#pragma unroll
                for (int kc = 0; kc < 2 * rt + 2; ++kc) O[rt] = MFMA32(LDSV(49152 + (rt * 4 + kc) * 1024), Ub[kc], O[rt]);
            const size_t tok0 = (size_t)b * 2048 + n * 64;
#pragma unroll
            for (int rt = 0; rt < 2; ++rt)
#pragma unroll
                for (int i = 0; i < 16; ++i) oraw[(tok0 + 32 * rt + crow(i, hh)) * 1024 + h * 128 + 32 * s + l31] = f2bf(O[rt][i]);
#pragma unroll
            for (int t = 0; t < 4; ++t) {
#pragma unroll
                for (int i = 0; i < 16; ++i) S[t][i] *= dl;
#pragma unroll
                for (int kc = 0; kc < 4; ++kc) S[t] = MFMA32(LDSV(32768 + (t * 4 + kc) * 1024), Ub[kc], S[t]);
            }
        }
        if (wid >= 4) { if (n + 3 < 32) asm volatile("s_waitcnt vmcnt(18)" ::: "memory"); else asm volatile("s_waitcnt vmcnt(0)" ::: "memory"); }
        else asm volatile("s_waitcnt lgkmcnt(0)" ::: "memory");
        GDN_BAR();
    }
    lds_barrier();
#undef GDN_BAR
#undef GDN_PF
#undef GDN_DMA
    if (wid < 4) {
        float* so = p.out + O_GSP + (size_t)bh * 16384;
#pragma unroll
        for (int t = 0; t < 4; ++t)
#pragma unroll
            for (int i = 0; i < 16; ++i) so[(32 * t + crow(i, hh)) * 128 + 32 * s + l31] = S[t][i];
    }
}

DI void gdn_sample_item(const Params& p, int item, unsigned char* smem) {
    float* raw = (float*)smem;
    float* nwT = raw + 3072;
    float* qeT = nwT + 1024;
    float* kdT = qeT + 1024;
    float* u0 = kdT + 1024;
    float* lowm = u0 + 1024;
    float* qkm = lowm + 64;
    float* Gs = qkm + 64;
    float* part = Gs + 32;
    const bf16_t* P0 = (const bf16_t*)(p.ws + WS_P0);
    int tid_ = threadIdx.x; asm volatile("" : "+v"(tid_));
    const int tid = tid_, lane = tid & 63, wid = tid >> 6;
    const int h = item & 7, b = item >> 3, tok0 = T_PR + b * 8;
#pragma unroll
    for (int m = 0; m < 6; ++m) {
        const int e = tid + 512 * m, row = e / 384, c3 = e - row * 384, sec = c3 >> 7, col = sec * 1024 + h * 128 + (c3 & 127);
        float o = 0.f;
#pragma unroll
        for (int j = 0; j < 4; ++j) { const int tr = row - 3 + j;
            const float x = tr >= 0 ? bf2f(P0[(size_t)(tok0 + tr) * LDP0 + col]) : p.st_conv[(size_t)(b * 3 + (3 + tr)) * 3072 + col];
            o += x * p.conv_w[j * 3072 + col]; }
        raw[sec * 1024 + row * 128 + (c3 & 127)] = silu_f(o);
    }
    if (tid < 8) {
        const float braw = bf2f(P0[(size_t)(tok0 + tid) * LDP0 + 4096 + h]), araw = bf2f(P0[(size_t)(tok0 + tid) * LDP0 + 4104 + h]);
        const float xx = araw + p.dt_bias[h]; const float sp = xx > 20.f ? xx : log1pf(expf(xx));
        Gs[16 + tid] = -expf(p.a_log[h]) * sp;
        Gs[8 + tid] = 1.f / (1.f + expf(-braw));
    }
    lds_barrier();
    { float q0 = raw[wid * 128 + lane], q1 = raw[wid * 128 + 64 + lane], k0 = raw[1024 + wid * 128 + lane], k1 = raw[1024 + wid * 128 + 64 + lane];
      const float sq = wave_sum(q0 * q0 + q1 * q1), sk = wave_sum(k0 * k0 + k1 * k1);
      const float cq = rsqrtf(sq + 1e-6f) * 0.08838834764831845f, ck = rsqrtf(sk + 1e-6f);
      raw[wid * 128 + lane] = q0 * cq; raw[wid * 128 + 64 + lane] = q1 * cq; raw[1024 + wid * 128 + lane] = k0 * ck; raw[1024 + wid * 128 + 64 + lane] = k1 * ck; }
    if (tid == 0) { float a = 0.f; for (int i = 0; i < 8; ++i) { a += Gs[16 + i]; Gs[i] = a; } }
    lds_barrier();
    if (tid < 8) Gs[24 + tid] = expf(Gs[tid]);
    { const int i = wid; const float ki0 = raw[1024 + i * 128 + lane], ki1 = raw[1024 + i * 128 + 64 + lane], qi0 = raw[i * 128 + lane], qi1 = raw[i * 128 + 64 + lane];
      for (int j = 0; j <= i; ++j) { const float kj0 = raw[1024 + j * 128 + lane], kj1 = raw[1024 + j * 128 + 64 + lane];
          const float kk = wave_sum(ki0 * kj0 + ki1 * kj1), qk = wave_sum(qi0 * kj0 + qi1 * kj1);
          const float dec = expf(Gs[i] - Gs[j]);
          if (lane == 0) { lowm[i * 8 + j] = (j < i) ? Gs[8 + i] * kk * dec : 0.f; qkm[i * 8 + j] = qk * dec; } } }
    lds_barrier();
    if (tid < 256) {
        const int isk = tid >> 7, cc = tid & 127; float sol[8];
#pragma unroll
        for (int i = 0; i < 8; ++i) { float r = Gs[8 + i] * (isk ? Gs[24 + i] * raw[1024 + i * 128 + cc] : raw[2048 + i * 128 + cc]);
#pragma unroll
            for (int j = 0; j < i; ++j) r -= lowm[i * 8 + j] * sol[j];
            sol[i] = r; }
#pragma unroll
        for (int i = 0; i < 8; ++i) { if (isk) nwT[cc * 8 + i] = -sol[i]; else u0[i * 128 + cc] = sol[i]; }
    } else {
        const int t2 = tid - 256, which = t2 >> 7, d = t2 & 127;
#pragma unroll
        for (int i = 0; i < 8; ++i) { if (which == 0) qeT[d * 8 + i] = raw[i * 128 + d] * Gs[24 + i]; else kdT[d * 8 + i] = raw[1024 + i * 128 + d] * expf(Gs[7] - Gs[i]); }
    }
    lds_barrier();
    const int dv = tid & 127, qt = tid >> 7;
    const float* S0 = p.st_gdn + (size_t)item * 16384;
    float pu[8], po[8];
#pragma unroll
    for (int c = 0; c < 8; ++c) { pu[c] = 0.f; po[c] = 0.f; }
#pragma unroll 1
    for (int r0 = 0; r0 < 32; r0 += 16) {
        float sv[16];
#pragma unroll
        for (int r = 0; r < 16; ++r) sv[r] = S0[(32 * qt + r0 + r) * 128 + dv];
#pragma unroll
        for (int r = 0; r < 16; ++r) { const int dk = 32 * qt + r0 + r;
            const f32x4 w0 = *(const f32x4*)(nwT + dk * 8), w1 = *(const f32x4*)(nwT + dk * 8 + 4), e0 = *(const f32x4*)(qeT + dk * 8), e1 = *(const f32x4*)(qeT + dk * 8 + 4);
            const float s = sv[r];
            pu[0] += w0.x * s; pu[1] += w0.y * s; pu[2] += w0.z * s; pu[3] += w0.w * s; pu[4] += w1.x * s; pu[5] += w1.y * s; pu[6] += w1.z * s; pu[7] += w1.w * s;
            po[0] += e0.x * s; po[1] += e0.y * s; po[2] += e0.z * s; po[3] += e0.w * s; po[4] += e1.x * s; po[5] += e1.y * s; po[6] += e1.z * s; po[7] += e1.w * s; }
    }
#pragma unroll
    for (int c = 0; c < 8; ++c) { part[(qt * 8 + c) * 128 + dv] = pu[c]; part[4096 + (qt * 8 + c) * 128 + dv] = po[c]; }
    lds_barrier();
    float u[8];
#pragma unroll
    for (int c = 0; c < 8; ++c) u[c] = u0[c * 128 + dv] + part[c * 128 + dv] + part[(8 + c) * 128 + dv] + part[(16 + c) * 128 + dv] + part[(24 + c) * 128 + dv];
    if (qt == 0) {
        bf16_t* oraw = (bf16_t*)(p.ws + WS_ORAW);
#pragma unroll
        for (int c = 0; c < 8; ++c) { float o = part[4096 + c * 128 + dv] + part[4096 + (8 + c) * 128 + dv] + part[4096 + (16 + c) * 128 + dv] + part[4096 + (24 + c) * 128 + dv];
#pragma unroll
            for (int j = 0; j <= c; ++j) o += qkm[c * 8 + j] * u[j];
            oraw[(size_t)(tok0 + c) * 1024 + h * 128 + dv] = f2bf(o); }
    }
    { const float dl = Gs[24 + 7]; float* So = p.out + O_GSS + (size_t)item * 16384;
#pragma unroll 1
      for (int r0 = 0; r0 < 32; r0 += 16) {
          float sv[16];
#pragma unroll
          for (int r = 0; r < 16; ++r) sv[r] = S0[(32 * qt + r0 + r) * 128 + dv];
#pragma unroll
          for (int r = 0; r < 16; ++r) { const int dk = 32 * qt + r0 + r; const f32x4 k0 = *(const f32x4*)(kdT + dk * 8), k1 = *(const f32x4*)(kdT + dk * 8 + 4);
              So[dk * 128 + dv] = dl * sv[r] + k0.x * u[0] + k0.y * u[1] + k0.z * u[2] + k0.w * u[3] + k1.x * u[4] + k1.y * u[5] + k1.z * u[6] + k1.w * u[7]; }
      } }
    lds_barrier();
}
DI void phase_gdn_scan(const Params& p, unsigned char* smem) {
    const int nscan = 64;
    if ((int)blockIdx.x < nscan) {
        _Pragma("unroll") for (int rp = 0; rp <= ((PROBE_MASK >> 13) & 1); ++rp)
        for (int bh = blockIdx.x; bh < 64; bh += nscan) gdn_scan_prompt(p, bh, smem);
    } else {
        _Pragma("unroll") for (int rp = 0; rp <= ((PROBE_MASK >> 14) & 1); ++rp)
        for (int item = blockIdx.x - nscan; item < 1024; item += gridDim.x - nscan) gdn_sample_item(p, item, smem);
    }
}

DI void phase_gdn_gate(const Params& p) {
    const int lane = threadIdx.x & 63, gw = blockIdx.x * 8 + (threadIdx.x >> 6), nw = gridDim.x * 8;
    const bf16_t* oraw = (const bf16_t*)(p.ws + WS_ORAW); const bf16_t* P0 = (const bf16_t*)(p.ws + WS_P0); bf16_t* og = (bf16_t*)(p.ws + WS_OG);
    for (int tok = gw; tok < T_TOK; tok += nw) {
        const u32x4 a0 = *(const u32x4*)(oraw + (size_t)tok * 1024 + 16 * lane), a1 = *(const u32x4*)(oraw + (size_t)tok * 1024 + 16 * lane + 8);
        const u32x4 z0 = *(const u32x4*)(P0 + (size_t)tok * LDP0 + 3072 + 16 * lane), z1 = *(const u32x4*)(P0 + (size_t)tok * LDP0 + 3072 + 16 * lane + 8);
        float o[16], z[16];
        const unsigned au[8] = {a0.x, a0.y, a0.z, a0.w, a1.x, a1.y, a1.z, a1.w}, zu[8] = {z0.x, z0.y, z0.z, z0.w, z1.x, z1.y, z1.z, z1.w};
        float ss = 0.f;
#pragma unroll
        for (int i = 0; i < 8; ++i) { o[2 * i] = bflo(au[i]); o[2 * i + 1] = bfhi(au[i]); z[2 * i] = bflo(zu[i]); z[2 * i + 1] = bfhi(zu[i]); ss += o[2 * i] * o[2 * i] + o[2 * i + 1] * o[2 * i + 1]; }
        ss += __shfl_xor(ss, 1); ss += __shfl_xor(ss, 2); ss += __shfl_xor(ss, 4);
        const float rstd = rsqrtf(ss * (1.f / 128.f) + 1e-6f);
        const int d0 = (16 * lane) & 127;
        unsigned r[8];
#pragma unroll
        for (int i = 0; i < 8; ++i) { const float v0 = o[2 * i] * rstd * p.onorm_a[d0 + 2 * i] * silu_f(z[2 * i]), v1 = o[2 * i + 1] * rstd * p.onorm_a[d0 + 2 * i + 1] * silu_f(z[2 * i + 1]); r[i] = pk_bf16(v0, v1); }
        *(u32x4*)(og + (size_t)tok * 1024 + 16 * lane) = (u32x4){r[0], r[1], r[2], r[3]};
        *(u32x4*)(og + (size_t)tok * 1024 + 16 * lane + 8) = (u32x4){r[4], r[5], r[6], r[7]};
    }
}

DI float ret_lg(int h) { return log1pf(-exp2f(-5.f - (float)h)); }
DI void rot_angle(double pos, double inv, float& sn, float& cs) {
    const double rev = pos * inv * 0.15915494309189535; const float fr = (float)(rev - rint(rev));
    sincosf(fr * 6.283185307179586f, &sn, &cs);
}
DI void phase_ret_prep(const Params& p, unsigned char* smem) {
    bf16_t* qr = (bf16_t*)smem;
    bf16_t* kr = qr + 64 * 264;
    bf16_t* vs = kr + 64 * 264;
    const bf16_t* P1 = (const bf16_t*)(p.ws + WS_P1);
    const f32x2* tabR = (const f32x2*)(p.ws + WS_TABR); const f32x2* tabC = (const f32x2*)(p.ws + WS_TABC);
    const int tid = opaque_tid(), lane = tid & 63, wid = tid >> 6, hh = lane >> 5, l31 = lane & 31;
    for (int item = blockIdx.x; item < 1024; item += gridDim.x) {
        const int n = item & 31, h = (item >> 5) & 3, b = item >> 7;
        const int tok0 = b * 2048 + n * 64;
        const float lg = ret_lg(h);
        unsigned char* blk = p.ws + WS_ROP + (size_t)item * ROP_STRIDE;
        bf16_t* o_qd = (bf16_t*)blk; bf16_t* o_kdT = o_qd + 16384; bf16_t* o_qkD = o_kdT + 16384; bf16_t* o_vT = o_qkD + 4096;
        u32x4 vreg[8];
#pragma unroll
        for (int m = 0; m < 8; ++m) { const int e = tid + 512 * m, row = (e >> 5) & 63, c8 = (e & 31) * 8, half = e >> 11;
            vreg[m] = *(const u32x4*)(P1 + (size_t)(tok0 + row) * LDP1 + 2048 + h * 512 + half * 256 + c8); }
#pragma unroll
        for (int m = 0; m < 2; ++m) {
            const int e = tid + 512 * m, row = e >> 4, i0 = (e & 15) * 8;
            const bf16_t* src = P1 + (size_t)(tok0 + row) * LDP1 + h * 256 + i0;
            const u32x4 q1 = *(const u32x4*)src, q2 = *(const u32x4*)(src + 128), k1 = *(const u32x4*)(src + 1024), k2 = *(const u32x4*)(src + 1152);
            const unsigned q1u[4] = {q1.x, q1.y, q1.z, q1.w}, q2u[4] = {q2.x, q2.y, q2.z, q2.w}, k1u[4] = {k1.x, k1.y, k1.z, k1.w}, k2u[4] = {k2.x, k2.y, k2.z, k2.w};
            float qa[8], qb[8], ka[8], kb[8];
#pragma unroll
            for (int j = 0; j < 8; ++j) {
                const f32x2 tr = tabR[row * 128 + i0 + j], tc = tabC[n * 128 + i0 + j];
                const float cs = tc.x * tr.x - tc.y * tr.y, sn = tc.y * tr.x + tc.x * tr.y;
                const float x1 = (j & 1) ? bfhi(q1u[j >> 1]) : bflo(q1u[j >> 1]), x2 = (j & 1) ? bfhi(q2u[j >> 1]) : bflo(q2u[j >> 1]);
                const float y1 = (j & 1) ? bfhi(k1u[j >> 1]) : bflo(k1u[j >> 1]), y2 = (j & 1) ? bfhi(k2u[j >> 1]) : bflo(k2u[j >> 1]);
                qa[j] = x1 * cs - x2 * sn; qb[j] = x1 * sn + x2 * cs;
                ka[j] = (y1 * cs - y2 * sn) * 0.0625f; kb[j] = (y1 * sn + y2 * cs) * 0.0625f;
            }
            const float qdec = expf(lg * (float)(row + 1));
            u32x4 w;
            w.x = pk_bf16(qa[0], qa[1]); w.y = pk_bf16(qa[2], qa[3]); w.z = pk_bf16(qa[4], qa[5]); w.w = pk_bf16(qa[6], qa[7]); *(u32x4*)(qr + row * 264 + i0) = w;
            w.x = pk_bf16(qb[0], qb[1]); w.y = pk_bf16(qb[2], qb[3]); w.z = pk_bf16(qb[4], qb[5]); w.w = pk_bf16(qb[6], qb[7]); *(u32x4*)(qr + row * 264 + 128 + i0) = w;
            w.x = pk_bf16(ka[0], ka[1]); w.y = pk_bf16(ka[2], ka[3]); w.z = pk_bf16(ka[4], ka[5]); w.w = pk_bf16(ka[6], ka[7]); *(u32x4*)(kr + row * 264 + i0) = w;
            w.x = pk_bf16(kb[0], kb[1]); w.y = pk_bf16(kb[2], kb[3]); w.z = pk_bf16(kb[4], kb[5]); w.w = pk_bf16(kb[6], kb[7]); *(u32x4*)(kr + row * 264 + 128 + i0) = w;
            { u32x2 w0, w1; bf16_t* fp = o_qd + ((((row >> 5) * 16 + (i0 >> 4)) * 64 + (row & 31)) << 3) + ((i0 >> 3) & 1) * 4;
              w0.x = pk_bf16(qa[0] * qdec, qa[1] * qdec); w0.y = pk_bf16(qa[2] * qdec, qa[3] * qdec); w1.x = pk_bf16(qa[4] * qdec, qa[5] * qdec); w1.y = pk_bf16(qa[6] * qdec, qa[7] * qdec);
              *(u32x2*)fp = w0; *(u32x2*)(fp + 32 * 8) = w1;
              w0.x = pk_bf16(qb[0] * qdec, qb[1] * qdec); w0.y = pk_bf16(qb[2] * qdec, qb[3] * qdec); w1.x = pk_bf16(qb[4] * qdec, qb[5] * qdec); w1.y = pk_bf16(qb[6] * qdec, qb[7] * qdec);
              *(u32x2*)(fp + 8 * 64 * 8) = w0; *(u32x2*)(fp + 8 * 64 * 8 + 32 * 8) = w1; }
        }
#pragma unroll
        for (int m = 0; m < 8; ++m) { const int e = tid + 512 * m, row = (e >> 5) & 63, c8 = (e & 31) * 8, half = e >> 11;
            *(u32x4*)(vs + half * (64 * 264) + row * 264 + c8) = vreg[m]; }
        lds_barrier();
        if (wid < 4) {
            const int ti = wid >> 1, tj = wid & 1;
            f32x16 acc;
#pragma unroll
            for (int i = 0; i < 16; ++i) acc[i] = 0.f;
            if (ti >= tj) {
#pragma unroll 4
                for (int ksp = 0; ksp < 16; ++ksp)
                    acc = MFMA32(ld16(qr + (32 * ti + l31) * 264 + 16 * ksp + 8 * hh), ld16(kr + (32 * tj + l31) * 264 + 16 * ksp + 8 * hh), acc);
            }
            const int col = 32 * tj + l31;
#pragma unroll
            for (int i = 0; i < 16; ++i) { const int row = 32 * ti + crow(i, hh);
                o_qkD[((((row >> 5) * 4 + (col >> 4)) * 64 + (row & 31) + 32 * ((col >> 3) & 1)) << 3) + (col & 7)] = f2bf(row >= col ? acc[i] * __expf(lg * (float)(row - col)) : 0.f); }
        } else {
            const int dk = tid - 256;
#pragma unroll
            for (int i0 = 0; i0 < 64; i0 += 8) { float v[8];
#pragma unroll
                for (int j = 0; j < 8; ++j) v[j] = bf2f(kr[(i0 + j) * 264 + dk]) * __expf(lg * (float)(63 - i0 - j));
                u32x4 w; w.x = pk_bf16(v[0], v[1]); w.y = pk_bf16(v[2], v[3]); w.z = pk_bf16(v[4], v[5]); w.w = pk_bf16(v[6], v[7]);
                *(u32x4*)(o_kdT + ((((dk >> 5) * 4 + (i0 >> 4)) * 64 + (dk & 31) + 32 * ((i0 >> 3) & 1)) << 3)) = w; }
        }
#pragma unroll
        for (int m = 0; m < 8; ++m) { const int e = tid + 512 * m, dv = e & 511, i0 = (e >> 9) * 8; unsigned short v[8];
            const bf16_t* vp = vs + (dv >> 8) * (64 * 264) + (dv & 255);
#pragma unroll
            for (int j = 0; j < 8; ++j) v[j] = vp[(i0 + j) * 264];
            u32x4 w; w.x = v[0] | ((unsigned)v[1] << 16); w.y = v[2] | ((unsigned)v[3] << 16); w.z = v[4] | ((unsigned)v[5] << 16); w.w = v[6] | ((unsigned)v[7] << 16);
            *(u32x4*)(o_vT + ((((dv >> 5) * 4 + (i0 >> 4)) * 64 + (dv & 31) + 32 * ((i0 >> 3) & 1)) << 3)) = w; }
        lds_barrier();
    }
}

DI void ret_scan_prompt(const Params& p, int item, unsigned char* smem) {
    LAS unsigned char* lds = (LAS unsigned char*)smem;
    const int tid = opaque_tid(), lane = tid & 63, wid = __builtin_amdgcn_readfirstlane(tid >> 6), hh = lane >> 5, l31 = lane & 31;
    const int half = item & 1, bh = item >> 1, h = bh & 3, b = bh >> 2, s = half * 8 + wid;
    const float sdec = expf(ret_lg(h) * 64.f);
    const unsigned char* gblk = p.ws + WS_ROP + (size_t)bh * 32 * ROP_STRIDE;
    bf16_t* oraw = (bf16_t*)(p.ws + WS_ORAW);
    LAS unsigned char* base = lds + lane * 16;
    f32x16 S[8];
#pragma unroll
    for (int t = 0; t < 8; ++t)
#pragma unroll
        for (int i = 0; i < 16; ++i) S[t][i] = 0.f;
    unsigned voff16 = lane * 16; asm volatile("" : "+v"(voff16));
#define RET_CP(goff, loff, npc) do { _Pragma("unroll") for (int i_ = 0; i_ < (npc); ++i_) { const int pc_ = wid + 8 * i_; \
        __builtin_amdgcn_global_load_lds((const unsigned*)((g_ + (goff) + pc_ * 1024) + voff16), (LAS unsigned*)(lds + (loff) + pc_ * 1024), 16, 0, 0); } } while (0)
#define RET_DMA_A(n) do { const unsigned char* g_ = gblk + (size_t)(n) * ROP_STRIDE; RET_CP(0, 0, 4); RET_CP(65536, 32768, 1); RET_CP(73728 + half * 32768, 73728 + ((n) & 1) * 32768, 4); } while (0)
#define RET_DMA_B(n) do { const unsigned char* g_ = gblk + (size_t)(n) * ROP_STRIDE; RET_CP(32768, 40960, 4); } while (0)
    lds_barrier();
    RET_DMA_A(0);
    asm volatile("s_waitcnt vmcnt(0)" ::: "memory"); lds_barrier();
    for (int n = 0; n < 32; ++n) {
        RET_DMA_B(n);
        f32x16 O[2];
#pragma unroll
        for (int rt = 0; rt < 2; ++rt)
#pragma unroll
            for (int i = 0; i < 16; ++i) O[rt][i] = 0.f;
        const int voff = 73728 + (n & 1) * 32768 + wid * 4096;
#pragma unroll
        for (int t = 0; t < 8; ++t)
#pragma unroll
            for (int s2 = 0; s2 < 2; ++s2) {
                const bf16x8 sb = packB(S[t], s2);
#pragma unroll
                for (int rt = 0; rt < 2; ++rt) O[rt] = MFMA32(LDSV((rt * 16 + 2 * t + s2) * 1024), sb, O[rt]);
                if (s2 == 1 && (t & 1)) __builtin_amdgcn_sched_barrier(0);
            }
#pragma unroll
        for (int rt = 0; rt < 2; ++rt)
#pragma unroll
            for (int kc = 0; kc < 2 * rt + 2; ++kc) O[rt] = MFMA32(LDSV(32768 + (rt * 4 + kc) * 1024), LDSV(voff + kc * 1024), O[rt]);
        const size_t tok0 = (size_t)b * 2048 + n * 64;
#pragma unroll
        for (int rt = 0; rt < 2; ++rt)
#pragma unroll
            for (int i = 0; i < 16; ++i) oraw[(tok0 + 32 * rt + crow(i, hh)) * 2048 + h * 512 + 32 * s + l31] = f2bf(O[rt][i]);
        asm volatile("s_waitcnt vmcnt(0)" ::: "memory"); lds_barrier();
        if (n + 1 < 32) RET_DMA_A(n + 1);
        bf16x8 Vb[4];
#pragma unroll
        for (int kc = 0; kc < 4; ++kc) Vb[kc] = LDSV(voff + kc * 1024);
#pragma unroll
        for (int t = 0; t < 8; ++t) {
#pragma unroll
            for (int i = 0; i < 16; ++i) S[t][i] *= sdec;
#pragma unroll
            for (int kc = 0; kc < 4; ++kc) S[t] = MFMA32(LDSV(40960 + (t * 4 + kc) * 1024), Vb[kc], S[t]);
            if (t & 1) __builtin_amdgcn_sched_barrier(0);
        }
        asm volatile("s_waitcnt vmcnt(0)" ::: "memory"); lds_barrier();
    }
#undef RET_CP
#undef RET_DMA_A
#undef RET_DMA_B
    float* so = p.out + O_RP + (size_t)bh * 131072;
#pragma unroll
    for (int t = 0; t < 8; ++t)
#pragma unroll
        for (int i = 0; i < 16; ++i) so[(32 * t + crow(i, hh)) * 512 + 32 * s + l31] = S[t][i];
}
DI void ret_sample_item(const Params& p, int item, unsigned char* smem) {
    float* qT = (float*)smem;
    float* kT = qT + 2048;
    float* qraw = kT + 2048;
    float* kraw = qraw + 2048;
    float* qkm = kraw + 2048;
    const bf16_t* P1 = (const bf16_t*)(p.ws + WS_P1);
    int tid_ = threadIdx.x; asm volatile("" : "+v"(tid_));
    const int tid = tid_, lane = tid & 63, wid = tid >> 6;
    const int h = item & 3, b = item >> 2, tok0 = T_PR + b * 8;
    const float lg = ret_lg(h);
#pragma unroll
    for (int m = 0; m < 2; ++m) {
        const int e = tid + 512 * m, row = e >> 7, i = e & 127;
        const f32x2 tsv = ((const f32x2*)(p.ws + WS_TABS))[row * 128 + i]; const float cs = tsv.x, sn = tsv.y;
        const bf16_t* src = P1 + (size_t)(tok0 + row) * LDP1 + h * 256 + i;
        const float x1 = bf2f(src[0]), x2 = bf2f(src[128]), y1 = bf2f(src[1024]), y2 = bf2f(src[1152]);
        const float qa = x1 * cs - x2 * sn, qb = x1 * sn + x2 * cs, ka = (y1 * cs - y2 * sn) * 0.0625f, kb = (y1 * sn + y2 * cs) * 0.0625f;
        const float qdec = expf(lg * (float)(row + 1)), kdec = expf(lg * (float)(7 - row));
        qraw[row * 256 + i] = qa; qraw[row * 256 + 128 + i] = qb; kraw[row * 256 + i] = ka; kraw[row * 256 + 128 + i] = kb;
        qT[i * 8 + row] = qa * qdec; qT[(128 + i) * 8 + row] = qb * qdec; kT[i * 8 + row] = ka * kdec; kT[(128 + i) * 8 + row] = kb * kdec;
    }
    lds_barrier();
    { const int i = wid;
      for (int j = 0; j <= i; ++j) { float a = 0.f;
#pragma unroll
          for (int q = 0; q < 4; ++q) a += qraw[i * 256 + lane + 64 * q] * kraw[j * 256 + lane + 64 * q];
          a = wave_sum(a);
          if (lane == 0) qkm[i * 8 + j] = a * expf(lg * (float)(i - j)); } }
    lds_barrier();
    float* red = (float*)(smem + 40960);
    float* vsh = (float*)(smem + 106496);
    const int dv4 = tid & 127, dkq = tid >> 7;
    f32x4 v[8], ao[8];
#pragma unroll
    for (int c = 0; c < 8; ++c) { const u32x2 vv = *(const u32x2*)(P1 + (size_t)(tok0 + c) * LDP1 + 2048 + h * 512 + 4 * dv4);
        v[c] = (f32x4){bflo(vv.x), bfhi(vv.x), bflo(vv.y), bfhi(vv.y)}; ao[c] = (f32x4){0.f, 0.f, 0.f, 0.f};
        if (dkq == 0) *(f32x4*)(vsh + c * 512 + 4 * dv4) = v[c]; }
    const float sdec = expf(lg * 8.f);
    const float* S0 = p.st_ret + (size_t)item * 131072 + 4 * dv4; float* So = p.out + O_RS + (size_t)item * 131072 + 4 * dv4;
#pragma unroll 1
    for (int dk0 = 64 * dkq; dk0 < 64 * dkq + 64; dk0 += 16) {
        f32x4 sv[16];
#pragma unroll
        for (int r = 0; r < 16; ++r) sv[r] = __builtin_nontemporal_load((const f32x4*)(S0 + (size_t)(dk0 + r) * 512));
#pragma unroll
        for (int r = 0; r < 16; ++r) { const int dk = dk0 + r;
            const f32x4 q0 = *(const f32x4*)(qT + dk * 8), q1 = *(const f32x4*)(qT + dk * 8 + 4), k0 = *(const f32x4*)(kT + dk * 8), k1 = *(const f32x4*)(kT + dk * 8 + 4);
            const f32x4 s = sv[r];
            ao[0] += q0.x * s; ao[1] += q0.y * s; ao[2] += q0.z * s; ao[3] += q0.w * s; ao[4] += q1.x * s; ao[5] += q1.y * s; ao[6] += q1.z * s; ao[7] += q1.w * s;
            const f32x4 sn = sdec * s + k0.x * v[0] + k0.y * v[1] + k0.z * v[2] + k0.w * v[3] + k1.x * v[4] + k1.y * v[5] + k1.z * v[6] + k1.w * v[7];
            __builtin_nontemporal_store(sn, (f32x4*)(So + (size_t)dk * 512)); }
    }
#pragma unroll
    for (int c = 0; c < 8; ++c) *(f32x4*)(red + (dkq * 8 + c) * 512 + 4 * dv4) = ao[c];
    lds_barrier();
    bf16_t* oraw = (bf16_t*)(p.ws + WS_ORAW);
    { const int dv = tid; float vc[8];
#pragma unroll
      for (int c = 0; c < 8; ++c) vc[c] = vsh[c * 512 + dv];
#pragma unroll
      for (int c = 0; c < 8; ++c) { float o = red[c * 512 + dv] + red[(8 + c) * 512 + dv] + red[(16 + c) * 512 + dv] + red[(24 + c) * 512 + dv];
#pragma unroll
          for (int j = 0; j <= c; ++j) o += qkm[c * 8 + j] * vc[j];
          oraw[(size_t)(tok0 + c) * 2048 + h * 512 + dv] = f2bf(o); } }
    lds_barrier();
}
DI void phase_ret_scan(const Params& p, unsigned char* smem) {
    const int nscan = 64;
    if ((int)blockIdx.x < nscan) {
        _Pragma("unroll") for (int rp = 0; rp <= ((PROBE_MASK >> 15) & 1); ++rp)
        for (int item = blockIdx.x; item < 64; item += nscan) ret_scan_prompt(p, item, smem);
    } else {
        _Pragma("unroll") for (int rp = 0; rp <= ((PROBE_MASK >> 16) & 1); ++rp)
        for (int item = blockIdx.x - nscan; item < 512; item += gridDim.x - nscan) ret_sample_item(p, item, smem);
    }
}

DI void phase_ret_gate(const Params& p) {
    const int lane = threadIdx.x & 63, gw = blockIdx.x * 8 + (threadIdx.x >> 6), nw = gridDim.x * 8;
    const bf16_t* oraw = (const bf16_t*)(p.ws + WS_ORAW); const bf16_t* P1 = (const bf16_t*)(p.ws + WS_P1); bf16_t* og = (bf16_t*)(p.ws + WS_OG);
    for (int tok = gw; tok < T_TOK; tok += nw) {
        float o[32]; float ss = 0.f;
#pragma unroll
        for (int q = 0; q < 4; ++q) { const u32x4 a = *(const u32x4*)(oraw + (size_t)tok * 2048 + 32 * lane + 8 * q); const unsigned au[4] = {a.x, a.y, a.z, a.w};
#pragma unroll
            for (int i = 0; i < 4; ++i) { o[8 * q + 2 * i] = bflo(au[i]); o[8 * q + 2 * i + 1] = bfhi(au[i]); ss += o[8 * q + 2 * i] * o[8 * q + 2 * i] + o[8 * q + 2 * i + 1] * o[8 * q + 2 * i + 1]; } }
        ss = row16_sum(ss);
        const float rstd = rsqrtf(ss * (1.f / 512.f) + 1e-6f);
        const float* wn = p.onorm_b + 32 * lane;
#pragma unroll
        for (int q = 0; q < 4; ++q) { const u32x4 g = *(const u32x4*)(P1 + (size_t)tok * LDP1 + 4096 + 32 * lane + 8 * q); const unsigned gu[4] = {g.x, g.y, g.z, g.w}; unsigned r[4];
#pragma unroll
            for (int i = 0; i < 4; ++i) { const float v0 = o[8 * q + 2 * i] * rstd * wn[8 * q + 2 * i] * silu_f(bflo(gu[i])), v1 = o[8 * q + 2 * i + 1] * rstd * wn[8 * q + 2 * i + 1] * silu_f(bfhi(gu[i])); r[i] = pk_bf16(v0, v1); }
            *(u32x4*)(og + (size_t)tok * 2048 + 32 * lane + 8 * q) = (u32x4){r[0], r[1], r[2], r[3]}; }
    }
}

DI void phase_norm1(const Params& p) {
    const int lane = threadIdx.x & 63, gw = blockIdx.x * 8 + (threadIdx.x >> 6), nw = gridDim.x * 8;
    float* x1 = (float*)(p.ws + WS_X1); const float* part = (const float*)(p.ws + WS_PART1); bf16_t* out = (bf16_t*)(p.ws + WS_XN); const float* w = p.norm_w + 1024;
    for (int tok = gw; tok < T_TOK; tok += nw) {
        f32x4 v[4]; float ss = 0.f;
#pragma unroll
        for (int i = 0; i < 4; ++i) { const int c = 4 * lane + 256 * i;
            if (tok < T_PR) v[i] = *(const f32x4*)(x1 + (size_t)tok * 1024 + c);
            else { const size_t o = (size_t)(tok - T_PR) * 1024 + c; v[i] = *(const f32x4*)(p.xs + o);
#pragma unroll
                for (int s = 0; s < 4; ++s) v[i] += *(const f32x4*)(part + (size_t)s * 1048576 + o);
                *(f32x4*)(x1 + (size_t)tok * 1024 + c) = v[i]; }
            ss += v[i].x * v[i].x + v[i].y * v[i].y + v[i].z * v[i].z + v[i].w * v[i].w; }
        ss = wave_sum(ss);
        const float rstd = rsqrtf(ss * (1.f / 1024.f) + 1e-6f);
#pragma unroll
        for (int i = 0; i < 4; ++i) { const f32x4 ww = *(const f32x4*)(w + 4 * lane + 256 * i);
            u32x2 o; o.x = pk_bf16(v[i].x * rstd * ww.x, v[i].y * rstd * ww.y); o.y = pk_bf16(v[i].z * rstd * ww.z, v[i].w * rstd * ww.w);
            *(u32x2*)(out + (size_t)tok * 1024 + 4 * lane + 256 * i) = o; }
    }
}

DI void phase_final(const Params& p) {
    const int lane = threadIdx.x & 63, gw = blockIdx.x * 8 + (threadIdx.x >> 6), nw = gridDim.x * 8;
    const float* x2 = (const float*)(p.ws + WS_X2);
    for (int tok = gw; tok < T_TOK; tok += nw) {
        f32x4 v[4]; float ss = 0.f;
#pragma unroll
        for (int i = 0; i < 4; ++i) { const int c = 4 * lane + 256 * i;
            if (tok < T_PR) v[i] = *(const f32x4*)(x2 + (size_t)tok * 1024 + c);
            else { const size_t o = (size_t)(tok - T_PR) * 1024 + c; v[i] = *(const f32x4*)((const float*)(p.ws + WS_X1) + (size_t)tok * 1024 + c);
#pragma unroll
                for (int s = 0; s < 8; ++s) v[i] += *(const f32x4*)((const float*)(p.ws + WS_PART2) + (size_t)s * 1048576 + o); }
            ss += v[i].x * v[i].x + v[i].y * v[i].y + v[i].z * v[i].z + v[i].w * v[i].w; }
        ss = wave_sum(ss);
        const float rstd = rsqrtf(ss * (1.f / 1024.f) + 1e-6f);
#pragma unroll
        for (int i = 0; i < 4; ++i) { const f32x4 ww = *(const f32x4*)(p.fnorm_w + 4 * lane + 256 * i);
            *(f32x4*)(p.out + O_Y + (size_t)tok * 1024 + 4 * lane + 256 * i) = (f32x4){v[i].x * rstd * ww.x, v[i].y * rstd * ww.y, v[i].z * rstd * ww.z, v[i].w * rstd * ww.w}; }
    }
}

__global__ void __launch_bounds__(512) hybrid_fwd(Params p) {
    extern __shared__ __attribute__((aligned(16))) unsigned char smem[];
    cg::grid_group grid = cg::this_grid();
    volatile LAS unsigned* xst = (volatile LAS unsigned*)((LAS unsigned char*)smem + SMEM_XB);
    if (threadIdx.x < 4) xst[threadIdx.x] = 0u;
    __syncthreads();
    const XcdBarrier xb = xcd_barrier_post((unsigned*)(p.ws + WS_BAR), xst);
#ifdef ONLY_PH
#define RUN(k) ((k) == ONLY_PH)
#define SYNC(k)
#else
#define RUN(k) (p.ph_lo <= (k) && (k) < p.ph_hi)
#define SYNC(k) if (p.ph_lo < (k) && (k) < p.ph_hi) { if (p.use_cg) grid.sync(); else { xcd_barrier(xb); if ((PROBE_MASK >> 17) & 1) xcd_barrier(xb); } }
#endif
    _Pragma("unroll") for (int rep = 0; rep <= ((PROBE_MASK >> 0) & 1); ++rep) if (RUN(0)) phase_prep(p, smem);
    SYNC(1);
    _Pragma("unroll") for (int rep = 0; rep <= ((PROBE_MASK >> 1) & 1); ++rep) if (RUN(1)) { pg8::Gemm g{(const bf16_t*)(p.ws + WS_XN), (const bf16_t*)(p.ws + WS_WTA), T_TOK, LDP0, 1024, 1024}; pg8::StaticOrder S; S.init(g.M, g.N, gridDim.x, blockIdx.x);
                  pg8::EpiBf16 E{(bf16_t*)(p.ws + WS_P0), LDP0}; pg8::gemm_phase((LAS unsigned char*)smem, g, S, E); }
    SYNC(2);
    _Pragma("unroll") for (int rep = 0; rep <= ((PROBE_MASK >> 2) & 1); ++rep) if (RUN(2)) phase_gdn_prep(p, smem);
    SYNC(3);
    _Pragma("unroll") for (int rep = 0; rep <= ((PROBE_MASK >> 3) & 1); ++rep) if (RUN(3)) phase_gdn_scan(p, smem);
    SYNC(4);
    _Pragma("unroll") for (int rep = 0; rep <= ((PROBE_MASK >> 4) & 1); ++rep) if (RUN(4)) phase_gdn_gate(p);
    SYNC(5);
    _Pragma("unroll") for (int rep = 0; rep <= ((PROBE_MASK >> 5) & 1); ++rep) if (RUN(5)) { pg8::Gemm g{(const bf16_t*)(p.ws + WS_OG), (const bf16_t*)(p.ws + WS_WTOA), T_TOK, 1024, 1024, 1024}; pg8::MainOrder S{(int)gridDim.x, (int)blockIdx.x};
                  pg8::EpiRes E{(float*)(p.ws + WS_X1), p.xp, p.xs, T_PR}; pg8::gemm_phase((LAS unsigned char*)smem, g, S, E);
                  pg8::Gemm gt{g.A, g.Bt, T_TOK, 1024, 256, 1024}; pg8::TailOrder St{(int)gridDim.x, (int)blockIdx.x, 4, 256};
                  pg8::EpiPart Et{(float*)(p.ws + WS_PART1)}; pg8::gemm_phase((LAS unsigned char*)smem, gt, St, Et); }
    SYNC(6);
    _Pragma("unroll") for (int rep = 0; rep <= ((PROBE_MASK >> 6) & 1); ++rep) if (RUN(6)) phase_norm1(p);
    SYNC(7);
    _Pragma("unroll") for (int rep = 0; rep <= ((PROBE_MASK >> 7) & 1); ++rep) if (RUN(7)) { pg8::Gemm g{(const bf16_t*)(p.ws + WS_XN), (const bf16_t*)(p.ws + WS_WTB), T_TOK, LDP1, 1024, 1024}; pg8::StaticOrder S; S.init(g.M, g.N, gridDim.x, blockIdx.x);
                  pg8::EpiBf16 E{(bf16_t*)(p.ws + WS_P1), LDP1}; pg8::gemm_phase((LAS unsigned char*)smem, g, S, E); }
    SYNC(8);
    _Pragma("unroll") for (int rep = 0; rep <= ((PROBE_MASK >> 8) & 1); ++rep) if (RUN(8)) phase_ret_prep(p, smem);
    SYNC(9);
    _Pragma("unroll") for (int rep = 0; rep <= ((PROBE_MASK >> 9) & 1); ++rep) if (RUN(9)) phase_ret_scan(p, smem);
    SYNC(10);
    _Pragma("unroll") for (int rep = 0; rep <= ((PROBE_MASK >> 10) & 1); ++rep) if (RUN(10)) phase_ret_gate(p);
    SYNC(11);
    _Pragma("unroll") for (int rep = 0; rep <= ((PROBE_MASK >> 11) & 1); ++rep) if (RUN(11)) { pg8::Gemm g{(const bf16_t*)(p.ws + WS_OG), (const bf16_t*)(p.ws + WS_WTOB), T_TOK, 1024, 2048, 2048}; pg8::MainOrder S{(int)gridDim.x, (int)blockIdx.x};
                   pg8::EpiRes E{(float*)(p.ws + WS_X2), (const float*)(p.ws + WS_X1), (const float*)(p.ws + WS_X1), T_TOK}; pg8::gemm_phase((LAS unsigned char*)smem, g, S, E);
                   pg8::Gemm gt{g.A, g.Bt, T_TOK, 1024, 256, 2048}; pg8::TailOrder St{(int)gridDim.x, (int)blockIdx.x, 8, 256};
                   pg8::EpiPart Et{(float*)(p.ws + WS_PART2)}; pg8::gemm_phase((LAS unsigned char*)smem, gt, St, Et); }
    SYNC(12);
    _Pragma("unroll") for (int rep = 0; rep <= ((PROBE_MASK >> 12) & 1); ++rep) if (RUN(12)) phase_final(p);
}

#ifndef N_LAUNCH_SPLIT
#define N_LAUNCH_SPLIT 0
#endif

extern "C" void kernel_launch(void* const* d_in, const int* in_sizes, int n_in, void* d_out, int out_size, void* d_ws, size_t ws_size, hipStream_t stream) {
    static int grid_blocks = 0;
    if (!grid_blocks) {
        hipFuncSetAttribute((const void*)hybrid_fwd, hipFuncAttributeMaxDynamicSharedMemorySize, (int)SMEM_BYTES);
        int dev = 0, cus = 0, per_cu = 0;
        hipGetDevice(&dev);
        hipDeviceGetAttribute(&cus, hipDeviceAttributeMultiprocessorCount, dev);
        hipOccupancyMaxActiveBlocksPerMultiprocessor(&per_cu, hybrid_fwd, 512, SMEM_BYTES);
        if (per_cu < 1) per_cu = 1;
        grid_blocks = cus * 1;
        if (grid_blocks < 72) { fprintf(stderr, "too few CUs: %d\n", grid_blocks); }
    }
    if (ws_size < WS_TOTAL) { fprintf(stderr, "workspace too small: %zu < %zu\n", ws_size, (size_t)WS_TOTAL); return; }
    hipMemsetAsync((unsigned char*)d_ws + WS_BAR, 0, 16384, stream);
    Params p{};
    p.xp = (const float*)d_in[0]; p.xs = (const float*)d_in[1]; p.st_gdn = (const float*)d_in[2]; p.st_conv = (const float*)d_in[3]; p.st_ret = (const float*)d_in[4];
    p.norm_w = (const float*)d_in[5]; p.w_in_a = (const float*)d_in[6]; p.conv_w = (const float*)d_in[7]; p.a_log = (const float*)d_in[8]; p.dt_bias = (const float*)d_in[9];
    p.onorm_a = (const float*)d_in[10]; p.w_out_a = (const float*)d_in[11]; p.w_in_b = (const float*)d_in[12]; p.onorm_b = (const float*)d_in[13]; p.w_out_b = (const float*)d_in[14];
    p.fnorm_w = (const float*)d_in[15];
    p.out = (float*)d_out; p.ws = (unsigned char*)d_ws;
#if N_LAUNCH_SPLIT
    for (int ph = 0; ph < NPH; ++ph) {
        p.ph_lo = ph; p.ph_hi = ph + 1;
        void* args[] = {&p};
        hipError_t e = hipLaunchCooperativeKernel((const void*)hybrid_fwd, dim3(grid_blocks), dim3(512), args, SMEM_BYTES, stream);
        if (e != hipSuccess) fprintf(stderr, "launch failed (phase %d): %s\n", ph, hipGetErrorString(e));
    }
#else
    p.ph_lo = 0; p.ph_hi = NPH;
    void* args[] = {&p};
    hipError_t e = hipLaunchCooperativeKernel((const void*)hybrid_fwd, dim3(grid_blocks), dim3(512), args, SMEM_BYTES, stream);
    if (e != hipSuccess) fprintf(stderr, "cooperative launch failed: %s (grid %d)\n", hipGetErrorString(e), grid_blocks);
#endif
}
```

```cpp
#include <hip/hip_runtime.h>
#include <hip/hip_cooperative_groups.h>
#include <cstdio>
namespace cg = cooperative_groups;

#define DI __device__ __forceinline__
#define LAS __attribute__((address_space(3)))
typedef unsigned short bf16_t;
typedef short bf16x8 __attribute__((ext_vector_type(8)));
typedef float f32x2 __attribute__((ext_vector_type(2)));
typedef float f32x4 __attribute__((ext_vector_type(4)));
typedef float f32x16 __attribute__((ext_vector_type(16)));
typedef unsigned u32x2 __attribute__((ext_vector_type(2)));
typedef unsigned u32x4 __attribute__((ext_vector_type(4)));
typedef __bf16 bf2_t __attribute__((ext_vector_type(2)));

constexpr int T_TOK = 17408, T_PR = 16384, DM = 1024;
constexpr int LDP0 = 4352, LDP1 = 6144;
constexpr int NPH = 13;
#ifndef PROBE_MASK
#define PROBE_MASK 0
#endif
constexpr size_t SMEM_BYTES = 153600;

constexpr size_t WS_WTA = 0;
constexpr size_t WS_WTOA = WS_WTA + (size_t)4352 * 1024 * 2;
constexpr size_t WS_WTB = WS_WTOA + (size_t)1024 * 1024 * 2;
constexpr size_t WS_WTOB = WS_WTB + (size_t)6144 * 1024 * 2;
constexpr size_t WS_XN = WS_WTOB + (size_t)1024 * 2048 * 2;
constexpr size_t WS_ORAW = WS_XN + (size_t)T_TOK * 1024 * 2;
constexpr size_t WS_OG = WS_ORAW + (size_t)T_TOK * 2048 * 2;
constexpr size_t WS_X1 = WS_OG + (size_t)T_TOK * 2048 * 2;
constexpr size_t WS_X2 = WS_X1 + (size_t)T_TOK * 1024 * 4;
constexpr size_t ROP_STRIDE = 139264;
constexpr size_t WS_ROP = WS_X2 + (size_t)T_TOK * 1024 * 4;
constexpr size_t WS_RA = WS_ROP + ROP_STRIDE * 1024;
constexpr size_t WS_P0 = WS_RA;
constexpr size_t GOP_STRIDE = 73984;
constexpr size_t WS_GOP = WS_P0 + (size_t)T_TOK * LDP0 * 2;
constexpr size_t WS_PART1 = WS_GOP;
constexpr size_t WS_PART2 = WS_ROP;
constexpr size_t WS_P1 = WS_RA;
constexpr size_t WS_END = WS_GOP + GOP_STRIDE * 2048;
static_assert((size_t)T_TOK * LDP1 * 2 <= WS_END - WS_RA, "P1 alias");
constexpr size_t WS_TABR = WS_END;
constexpr size_t WS_TABC = WS_TABR + 65536;
constexpr size_t WS_TABS = WS_TABC + 32768;
constexpr size_t WS_BAR = WS_TABS + 8192;
constexpr size_t WS_TOTAL = WS_BAR + 16384;
constexpr size_t SMEM_XB = 147456;

constexpr size_t O_Y = 0, O_GSP = 17825792, O_GCP = 18874368, O_RP = 18948096, O_GSS = 23142400, O_GCS = 39919616, O_RS = 41099264;

struct Params {
    const float *xp, *xs, *st_gdn, *st_conv, *st_ret, *norm_w, *w_in_a, *conv_w, *a_log, *dt_bias, *onorm_a, *w_out_a, *w_in_b, *onorm_b, *w_out_b, *fnorm_w;
    float* out;
    unsigned char* ws;
    int ph_lo, ph_hi;
    int use_cg, pad0;
};

DI unsigned pk_bf16(float a, float b) { f32x2 v = {a, b}; bf2_t r = __builtin_convertvector(v, bf2_t); return __builtin_bit_cast(unsigned, r); }
DI bf16_t f2bf(float a) { return (bf16_t)(pk_bf16(a, 0.f) & 0xffffu); }
DI float bf2f(bf16_t b) { return __uint_as_float(((unsigned)b) << 16); }
DI float bflo(unsigned u) { return __uint_as_float(u << 16); }
DI float bfhi(unsigned u) { return __uint_as_float(u & 0xffff0000u); }
DI float silu_f(float x) { return x * __builtin_amdgcn_rcpf(1.f + __expf(-x)); }
DI float row16_sum(float v) {
    v += __builtin_bit_cast(float, __builtin_amdgcn_update_dpp(0, __builtin_bit_cast(int, v), 0xB1, 0xF, 0xF, true));
    v += __builtin_bit_cast(float, __builtin_amdgcn_update_dpp(0, __builtin_bit_cast(int, v), 0x4E, 0xF, 0xF, true));
    v += __builtin_bit_cast(float, __builtin_amdgcn_update_dpp(0, __builtin_bit_cast(int, v), 0x124, 0xF, 0xF, true));
    v += __builtin_bit_cast(float, __builtin_amdgcn_update_dpp(0, __builtin_bit_cast(int, v), 0x128, 0xF, 0xF, true));
    return v;
}
DI float wave_sum(float v) {
    v = row16_sum(v);
    v += __shfl_xor(v, 16);
    v += __shfl_xor(v, 32);
    return v;
}
DI bf16x8 packB(const f32x16& x, const int s) {
    u32x4 p; p.x = pk_bf16(x[8 * s], x[8 * s + 1]); p.y = pk_bf16(x[8 * s + 2], x[8 * s + 3]); p.z = pk_bf16(x[8 * s + 4], x[8 * s + 5]); p.w = pk_bf16(x[8 * s + 6], x[8 * s + 7]);
    return __builtin_bit_cast(bf16x8, p);
}
DI bf16x8 ldA_perm(const bf16_t* rowp, int hh) {
    const u32x2 lo = *(const u32x2*)(rowp + 4 * hh), hi = *(const u32x2*)(rowp + 8 + 4 * hh);
    u32x4 v = {lo.x, lo.y, hi.x, hi.y}; return __builtin_bit_cast(bf16x8, v);
}
DI bf16x8 ld16(const bf16_t* p) { return __builtin_bit_cast(bf16x8, *(const u32x4*)p); }
#define MFMA32(a, b, c) __builtin_amdgcn_mfma_f32_32x32x16_bf16((a), (b), (c), 0, 0, 0)
DI void split2(float a, float b, unsigned& hi, unsigned& lo) { hi = pk_bf16(a, b); lo = pk_bf16(a - bflo(hi), b - bfhi(hi)); }
DI void split8(const f32x4& v0, const f32x4& v1, bf16x8& hi, bf16x8& lo) {
    unsigned h0, h1, h2, h3, l0, l1, l2, l3; split2(v0.x, v0.y, h0, l0); split2(v0.z, v0.w, h1, l1); split2(v1.x, v1.y, h2, l2); split2(v1.z, v1.w, h3, l3);
    const u32x4 h = {h0, h1, h2, h3}, l = {l0, l1, l2, l3};
    hi = __builtin_bit_cast(bf16x8, h); lo = __builtin_bit_cast(bf16x8, l);
}
DI void split4z(float a, float b, float c, float d, bf16x8& hi, bf16x8& lo) {
    unsigned h0, h1, l0, l1; split2(a, b, h0, l0); split2(c, d, h1, l1);
    const u32x4 h = {h0, h1, 0u, 0u}, l = {l0, l1, 0u, 0u};
    hi = __builtin_bit_cast(bf16x8, h); lo = __builtin_bit_cast(bf16x8, l);
}
DI int crow(int i, int hh) { return (i & 3) + 8 * (i >> 2) + 4 * hh; }
DI void lds_barrier() { asm volatile("s_waitcnt lgkmcnt(0)" ::: "memory"); __builtin_amdgcn_s_barrier(); asm volatile("" ::: "memory"); }
DI int opaque_tid() { int t = threadIdx.x; asm volatile("" : "+v"(t)); return t; }


#define XB_TMO      128
#define XB_XCNT(j)  (256  + 64 * (j))
#define XB_XSUB(j)  (1280 + 64 * (j))
#define XB_XGEN(j)  (2304 + 64 * (j))
#define XB_TOP      3328
#define XB_TOPGEN   3392
#define XCD_BAR_WORDS 3456
#define XB_SPIN_CAP (1u << 18)
DI unsigned xb_ld(unsigned* p) { return __hip_atomic_load(p, __ATOMIC_RELAXED, __HIP_MEMORY_SCOPE_AGENT); }
DI unsigned xb_add(unsigned* p, unsigned v) { return __hip_atomic_fetch_add(p, v, __ATOMIC_RELAXED, __HIP_MEMORY_SCOPE_AGENT); }
DI unsigned xb_xcc_id() { return (unsigned)__builtin_amdgcn_s_getreg((3 << 11) | 20) & 0xFu; }
#define XB_SPIN(cond, bar) do { unsigned _sp = 0; while (cond) { __builtin_amdgcn_s_sleep(1); \
    if ((++_sp & 255u) == 0u) { if (xb_ld(&(bar)[XB_TMO])) break; if (_sp > XB_SPIN_CAP) { atomicAdd(&(bar)[XB_TMO], 1u); break; } } } } while (0)
struct XcdBarrier { unsigned* bar; unsigned x; volatile LAS unsigned* st; };
DI XcdBarrier xcd_barrier_post(unsigned* bar, volatile LAS unsigned* st) {
    XcdBarrier b; b.bar = bar; b.x = xb_xcc_id(); b.st = st;
    if (threadIdx.x == 0) (void)xb_add(&bar[XB_XCNT(b.x)], 1u);
    return b;
}
DI void xcd_barrier_complete(unsigned* bar, unsigned x, unsigned& nloc, unsigned& nx) {
    const unsigned G = gridDim.x * gridDim.y * gridDim.z;
    unsigned sum, cnt, mine, sp = 0u;
    for (;;) {
        sum = 0u; cnt = 0u; mine = 0u;
#pragma unroll
        for (unsigned j = 0; j < 16; ++j) { const unsigned c = xb_ld(&bar[XB_XCNT(j)]); sum += c; cnt += (c > 0u) ? 1u : 0u; mine = (j == x) ? c : mine; }
        if (sum == G) break;
        __builtin_amdgcn_s_sleep(1);
        if ((++sp & 255u) == 0u) { if (xb_ld(&bar[XB_TMO])) break; if (sp > XB_SPIN_CAP) { atomicAdd(&bar[XB_TMO], 1u); break; } }
    }
    nloc = mine > 0u ? mine : 1u; nx = cnt > 0u ? cnt : 1u;
}
DI void xcd_barrier_slow(unsigned* bar, unsigned x, volatile LAS unsigned* st) {
    __builtin_amdgcn_s_waitcnt(0);
    unsigned nloc = st[0], nx = st[1];
    if (nloc == 0u) { xcd_barrier_complete(bar, x, nloc, nx); st[0] = nloc; st[1] = nx; }
    const unsigned old = xb_add(&bar[XB_XSUB(x)], 1u);
    const unsigned gen = old / nloc;
    if (old + 1u == (gen + 1u) * nloc) {
        __builtin_amdgcn_fence(__ATOMIC_RELEASE, "agent");
        asm volatile("s_waitcnt vmcnt(0)" ::: "memory");
        const unsigned og = xb_add(&bar[XB_TOP], 1u);
        const unsigned tg = og / nx;
        if (og + 1u == (tg + 1u) * nx) xb_add(&bar[XB_TOPGEN], 1u);
        else XB_SPIN(xb_ld(&bar[XB_TOPGEN]) == tg, bar);
        __builtin_amdgcn_fence(__ATOMIC_ACQUIRE, "agent");
        xb_add(&bar[XB_XGEN(x)], 1u);
        asm volatile("s_waitcnt vmcnt(0)" ::: "memory");
    } else {
        XB_SPIN(xb_ld(&bar[XB_XGEN(x)]) == gen, bar);
        __builtin_amdgcn_fence(__ATOMIC_ACQUIRE, "agent");
        asm volatile("s_waitcnt vmcnt(0)" ::: "memory");
    }
}
DI void xcd_barrier(const XcdBarrier& b) {
    asm volatile("s_waitcnt vmcnt(0)" ::: "memory");
    __syncthreads();
    if (threadIdx.x == 0) xcd_barrier_slow(b.bar, b.x, b.st);
    __syncthreads();
}

namespace pg8 {
constexpr int BM = 256, BK = 64, HALF = 128, HTB = HALF * BK * 2, STAGE_BYTES = 8 * HTB, NXCD = 8, WGM = 8;
DI int lds_byte(int r, int c) { const int st = (r >> 4) * 2 + (c >> 5), rr = r & 15, cc = c & 31, ob = rr * 64 + cc * 2; return st * 1024 + (ob ^ (((ob >> 9) & 1) << 5)); }
DI void stage_rc(int b, int& R, int& C) { const int st = b / 1024, sb = b % 1024, swz = sb ^ (((sb >> 9) & 1) << 5); R = (st >> 1) * 16 + swz / 64; C = (st & 1) * 32 + (swz % 64) / 2; }
DI int perm32(int rho) { const int n = rho >> 4, i = rho & 15; return 8 * (i >> 2) + 4 * n + (i & 3); }
struct Unit { int pm, pn, koff, slice; };
struct Gemm { const bf16_t* A; const bf16_t* Bt; int M, N, K, ld; };
struct StaticOrder {
    int nM, nN, nwg, G, c;
    DI void init(int M, int N, int G_, int c_) { nM = M / BM; nN = N / BM; nwg = nM * nN; G = G_; c = c_; }
    DI bool next(int i, Unit& u) const {
        const long L = (long)i * G + c; if (L >= nwg) return false;
        int wgid = (int)L; { const int q = nwg / NXCD, r = nwg % NXCD, xcd = wgid % NXCD, off = wgid / NXCD; wgid = (xcd < r ? xcd * (q + 1) : r * (q + 1) + (xcd - r) * q) + off; }
        const int nig = WGM * nN, gid = wgid / nig, fm = gid * WGM, gsz = (nM - fm) < WGM ? (nM - fm) : WGM;
        u.pm = fm + ((wgid % nig) % gsz); u.pn = (wgid % nig) / gsz; u.koff = 0; u.slice = 0; return true;
    }
};
struct MainOrder { int G, c; DI bool next(int i, Unit& u) const { const int L = i * G + c; if (L >= 256) return false; u.pm = L >> 2; u.pn = L & 3; u.koff = 0; u.slice = 0; return true; } };
struct TailOrder { int G, c, NS, klen; DI bool next(int i, Unit& u) const { const int L = i * G + c; if (L >= 16 * NS) return false; const int un = L / NS; u.slice = L - un * NS; u.pm = 64 + (un >> 2); u.pn = un & 3; u.koff = u.slice * klen; return true; } };
struct EpiBf16 {
    static constexpr bool PERM = true;
    bf16_t* O; int ldc;
    DI void operator()(const f32x4 (&acc)[2][2][4][2], const Unit& u, int wr, int wc, int fr, int fq) const {
        const int row0 = u.pm * BM + wr * 64 + fr, col0 = u.pn * BM + wc * 32 + 8 * fq;
#pragma unroll
        for (int ai = 0; ai < 2; ++ai)
#pragma unroll
            for (int m = 0; m < 4; ++m) { bf16_t* rowp = O + (size_t)(row0 + ai * HALF + m * 16) * ldc + col0;
#pragma unroll
                for (int bj = 0; bj < 2; ++bj) { const f32x4 v0 = acc[ai][bj][m][0], v1 = acc[ai][bj][m][1];
                    u32x4 w; w.x = pk_bf16(v0[0], v0[1]); w.y = pk_bf16(v0[2], v0[3]); w.z = pk_bf16(v1[0], v1[1]); w.w = pk_bf16(v1[2], v1[3]);
                    *(u32x4*)(rowp + bj * HALF) = w; } }
    }
};
struct EpiRes {
    static constexpr bool PERM = false;
    float* O; const float* resA; const float* resB; int split;
    DI void operator()(const f32x4 (&acc)[2][2][4][2], const Unit& u, int wr, int wc, int fr, int fq) const {
        const int row0 = u.pm * BM + wr * 64 + fr, col0 = u.pn * BM + wc * 32 + 4 * fq;
#pragma unroll
        for (int ai = 0; ai < 2; ++ai)
#pragma unroll
            for (int m = 0; m < 4; ++m) { const int r = row0 + ai * HALF + m * 16;
                const float* rp = (r < split ? resA + (size_t)r * 1024 : resB + (size_t)(r - split) * 1024) + col0; float* op = O + (size_t)r * 1024 + col0;
#pragma unroll
                for (int bj = 0; bj < 2; ++bj)
#pragma unroll
                    for (int n = 0; n < 2; ++n) *(f32x4*)(op + bj * HALF + n * 16) = acc[ai][bj][m][n] + *(const f32x4*)(rp + bj * HALF + n * 16); }
    }
};

struct EpiPart {
    static constexpr bool PERM = false;
    float* P;
    DI void operator()(const f32x4 (&acc)[2][2][4][2], const Unit& u, int wr, int wc, int fr, int fq) const {
        const int row0 = (u.pm - 64) * BM + wr * 64 + fr, col0 = u.pn * BM + wc * 32 + 4 * fq;
        float* base = P + (size_t)u.slice * 1048576;
#pragma unroll
        for (int ai = 0; ai < 2; ++ai)
#pragma unroll
            for (int m = 0; m < 4; ++m) { float* op = base + (size_t)(row0 + ai * HALF + m * 16) * 1024 + col0;
#pragma unroll
                for (int bj = 0; bj < 2; ++bj)
#pragma unroll
                    for (int n = 0; n < 2; ++n) *(f32x4*)(op + bj * HALF + n * 16) = acc[ai][bj][m][n]; }
    }
};

template <class Epi, class Sched>
DI void gemm_phase(LAS unsigned char* lds, const Gemm g, const Sched& S, const Epi& E) {
    const int tid = opaque_tid(), wid = __builtin_amdgcn_readfirstlane(tid >> 6), lane = tid & 63, wr = wid >> 2, wc = wid & 3, fr = lane & 15, fq = lane >> 4;
    const int K = g.ld, nt = g.K / BK;
    unsigned voffA[2], voffB[2];
#pragma unroll
    for (int i = 0; i < 2; ++i) { int R, C; stage_rc(tid * 16 + i * 8192, R, C); const int Rb = Epi::PERM ? ((R & ~31) + perm32(R & 31)) : R;
        voffA[i] = (unsigned)(R * K + C) * 2u; voffB[i] = (unsigned)(Rb * K + C) * 2u; }
    const size_t kstep = (size_t)(BK * 2);
    const size_t hstep = (size_t)HALF * K * 2;
    const size_t tstep = 2 * hstep;
    const unsigned ldsw = (unsigned)wid * 1024u;
    const int aoff = lds_byte(wr * 64 + fr, fq * 8), boff = lds_byte(wc * 32 + fr, fq * 8);
#define PG8_SA(b, h) (((b) * 2 + (h)) * HTB)
#define PG8_SB(b, h) ((4 + (b) * 2 + (h)) * HTB)
#define PG8_STAGE(bufoff, gbase, voff) do { _Pragma("unroll") for (int _i = 0; _i < 2; ++_i) \
        __builtin_amdgcn_global_load_lds((const unsigned*)((const char*)(gbase) + (voff)[_i]), (LAS unsigned*)(lds + (bufoff) + ldsw + _i * 8192), 16, 0, 0); } while (0)
#define PG8_LDA(dst, b, h) do { _Pragma("unroll") for (int m = 0; m < 4; ++m) _Pragma("unroll") for (int k = 0; k < 2; ++k) dst[m][k] = *(const LAS bf16x8*)(lds + PG8_SA(b, h) + aoff + m * 2048 + k * 1024); } while (0)
#define PG8_LDB(dst, b, h) do { _Pragma("unroll") for (int n = 0; n < 2; ++n) _Pragma("unroll") for (int k = 0; k < 2; ++k) dst[n][k] = *(const LAS bf16x8*)(lds + PG8_SB(b, h) + boff + n * 2048 + k * 1024); } while (0)
#define PG8_MMA(ai, bj, At, Bt) do { __builtin_amdgcn_s_setprio(1); _Pragma("unroll") for (int m = 0; m < 4; ++m) _Pragma("unroll") for (int n = 0; n < 2; ++n) _Pragma("unroll") for (int k = 0; k < 2; ++k) \
        acc[ai][bj][m][n] = __builtin_amdgcn_mfma_f32_16x16x32_bf16(Bt[n][k], At[m][k], acc[ai][bj][m][n], 0, 0, 0); __builtin_amdgcn_s_setprio(0); } while (0)
#define PG8_WAIT_V(n) asm volatile("s_waitcnt vmcnt(" #n ")" ::: "memory")
#define PG8_WAIT_L(n) asm volatile("s_waitcnt lgkmcnt(" #n ")" ::: "memory")
#define PG8_BAR __builtin_amdgcn_s_barrier()
#define PG8_SCHED __builtin_amdgcn_sched_barrier(0)
    Unit cur, nxt; int ui = 0;
    if (!S.next(0, cur)) return;
    f32x4 acc[2][2][4][2];
#pragma unroll
    for (int a = 0; a < 2; ++a)
#pragma unroll
        for (int b = 0; b < 2; ++b)
#pragma unroll
            for (int m = 0; m < 4; ++m)
#pragma unroll
                for (int n = 0; n < 2; ++n) acc[a][b][m][n] = (f32x4){0.f, 0.f, 0.f, 0.f};
    bf16x8 At[4][2], B0[2][2], B1[2][2];
    const char* cA = (const char*)g.A + (size_t)cur.pm * tstep + (size_t)cur.koff * 2; const char* cB = (const char*)g.Bt + (size_t)cur.pn * tstep + (size_t)cur.koff * 2;
    PG8_STAGE(PG8_SB(0, 0), cB, voffB); PG8_STAGE(PG8_SA(0, 0), cA, voffA); PG8_STAGE(PG8_SB(0, 1), cB + hstep, voffB); PG8_STAGE(PG8_SA(0, 1), cA + hstep, voffA);
    if (wr == 1) PG8_BAR;
    PG8_WAIT_V(4); PG8_BAR;
    PG8_STAGE(PG8_SB(1, 0), cB + kstep, voffB); PG8_STAGE(PG8_SA(1, 0), cA + kstep, voffA); PG8_STAGE(PG8_SB(1, 1), cB + hstep + kstep, voffB);
    PG8_WAIT_V(6); PG8_BAR;
    for (;;) {
        const bool has_next = S.next(ui + 1, nxt);
        const char* nA = has_next ? (const char*)g.A + (size_t)nxt.pm * tstep + (size_t)nxt.koff * 2 : cA; const char* nB = has_next ? (const char*)g.Bt + (size_t)nxt.pn * tstep + (size_t)nxt.koff * 2 : cB;
        for (int t = 0; t < nt; t += 2) {
            const bool last = (t == nt - 2);
            const char* a1 = cA + (size_t)(t + 1) * kstep;
            const char* a2 = last ? nA : cA + (size_t)(t + 2) * kstep; const char* b2 = last ? nB : cB + (size_t)(t + 2) * kstep;
            const char* a3 = a2 + kstep; const char* b3 = b2 + kstep;
            PG8_LDB(B0, 0, 0); PG8_SCHED; PG8_LDA(At, 0, 0); PG8_STAGE(PG8_SA(1, 1), a1 + hstep, voffA);
            PG8_WAIT_L(8); PG8_BAR; PG8_WAIT_L(0); PG8_MMA(0, 0, At, B0); PG8_BAR; PG8_SCHED;
            PG8_LDB(B1, 0, 1); PG8_STAGE(PG8_SB(0, 0), b2, voffB);
            PG8_BAR; PG8_WAIT_L(0); PG8_MMA(0, 1, At, B1); PG8_BAR;
            PG8_LDA(At, 0, 1); PG8_STAGE(PG8_SA(0, 0), a2, voffA);
            PG8_BAR; PG8_WAIT_L(0); PG8_MMA(1, 0, At, B0); PG8_BAR; PG8_SCHED;
            PG8_STAGE(PG8_SB(0, 1), b2 + hstep, voffB);
            PG8_WAIT_V(6); PG8_BAR; PG8_MMA(1, 1, At, B1); PG8_BAR;
            PG8_LDB(B0, 1, 0); PG8_SCHED; PG8_LDA(At, 1, 0); PG8_STAGE(PG8_SA(0, 1), a2 + hstep, voffA);
            PG8_WAIT_L(8); PG8_BAR; PG8_WAIT_L(0); PG8_MMA(0, 0, At, B0); PG8_BAR; PG8_SCHED;
            PG8_LDB(B1, 1, 1); PG8_STAGE(PG8_SB(1, 0), b3, voffB);
            PG8_BAR; PG8_WAIT_L(0); PG8_MMA(0, 1, At, B1); PG8_BAR;
            PG8_LDA(At, 1, 1); PG8_STAGE(PG8_SA(1, 0), a3, voffA);
            PG8_BAR; PG8_WAIT_L(0); PG8_MMA(1, 0, At, B0); PG8_BAR; PG8_SCHED;
            PG8_STAGE(PG8_SB(1, 1), b3 + hstep, voffB);
            PG8_WAIT_V(6); PG8_BAR; PG8_MMA(1, 1, At, B1); PG8_BAR;
        }
        E(acc, cur, wr, wc, fr, fq);
        if (!has_next) break;
#pragma unroll
        for (int a = 0; a < 2; ++a)
#pragma unroll
            for (int b = 0; b < 2; ++b)
#pragma unroll
                for (int m = 0; m < 4; ++m)
#pragma unroll
                    for (int n = 0; n < 2; ++n) acc[a][b][m][n] = (f32x4){0.f, 0.f, 0.f, 0.f};
        cur = nxt; cA = nA; cB = nB; ++ui;
    }
    PG8_WAIT_V(0);
    if (wr == 0) PG8_BAR;
    PG8_BAR;
#undef PG8_SA
#undef PG8_SB
#undef PG8_STAGE
#undef PG8_LDA
#undef PG8_LDB
#undef PG8_MMA
#undef PG8_WAIT_V
#undef PG8_WAIT_L
#undef PG8_BAR
#undef PG8_SCHED
}
}

DI void transpose_tile(const float* W, int ldw, int nvalid, int k0, int n0, bf16_t* Wt, int ldt, float* tile  ) {
    const int tid = threadIdx.x;
#pragma unroll
    for (int m = 0; m < 8; ++m) { const int e = tid + 512 * m, kk = e >> 6, nn = e & 63;
        tile[kk * 65 + nn] = (n0 + nn < nvalid) ? W[(size_t)(k0 + kk) * ldw + n0 + nn] : 0.f; }
    lds_barrier();
    { const int nn = tid >> 3, kq = tid & 7; float v[8];
#pragma unroll
      for (int j = 0; j < 8; ++j) v[j] = tile[(kq * 8 + j) * 65 + nn];
      u32x4 w; w.x = pk_bf16(v[0], v[1]); w.y = pk_bf16(v[2], v[3]); w.z = pk_bf16(v[4], v[5]); w.w = pk_bf16(v[6], v[7]);
      *(u32x4*)(Wt + (size_t)(n0 + nn) * ldt + k0 + kq * 8) = w; }
    lds_barrier();
}
DI void rmsnorm_bf16(const float* srcA, const float* srcB, int split, const float* w, bf16_t* out) {
    const int lane = threadIdx.x & 63, gw = blockIdx.x * 8 + (threadIdx.x >> 6), nw = gridDim.x * 8;
    for (int tok = gw; tok < T_TOK; tok += nw) {
        const float* src = tok < split ? srcA + (size_t)tok * 1024 : srcB + (size_t)(tok - split) * 1024;
        f32x4 v[4]; float ss = 0.f;
#pragma unroll
        for (int i = 0; i < 4; ++i) { v[i] = *(const f32x4*)(src + 4 * lane + 256 * i); ss += v[i].x * v[i].x + v[i].y * v[i].y + v[i].z * v[i].z + v[i].w * v[i].w; }
        ss = wave_sum(ss);
        const float rstd = rsqrtf(ss * (1.f / 1024.f) + 1e-6f);
#pragma unroll
        for (int i = 0; i < 4; ++i) { const f32x4 ww = *(const f32x4*)(w + 4 * lane + 256 * i);
            u32x2 o; o.x = pk_bf16(v[i].x * rstd * ww.x, v[i].y * rstd * ww.y); o.y = pk_bf16(v[i].z * rstd * ww.z, v[i].w * rstd * ww.w);
            *(u32x2*)(out + (size_t)tok * 1024 + 4 * lane + 256 * i) = o; }
    }
}
DI void phase_prep(const Params& p, unsigned char* smem) {
    float* tile = (float*)smem;
    bf16_t* wta = (bf16_t*)(p.ws + WS_WTA); bf16_t* wtoa = (bf16_t*)(p.ws + WS_WTOA); bf16_t* wtb = (bf16_t*)(p.ws + WS_WTB); bf16_t* wtob = (bf16_t*)(p.ws + WS_WTOB);
    for (int t = blockIdx.x; t < 3392; t += gridDim.x) {
        if (t < 1088) transpose_tile(p.w_in_a, 4112, 4112, (t & 15) * 64, (t >> 4) * 64, wta, 1024, tile);
        else if (t < 1344) { const int u = t - 1088; transpose_tile(p.w_out_a, 1024, 1024, (u & 15) * 64, (u >> 4) * 64, wtoa, 1024, tile); }
        else if (t < 2880) { const int u = t - 1344; transpose_tile(p.w_in_b, 6144, 6144, (u & 15) * 64, (u >> 4) * 64, wtb, 1024, tile); }
        else { const int u = t - 2880; transpose_tile(p.w_out_b, 1024, 1024, (u & 31) * 64, (u >> 5) * 64, wtob, 2048, tile); }
    }
    rmsnorm_bf16(p.xp, p.xs, T_PR, p.norm_w, (bf16_t*)(p.ws + WS_XN));
    for (int e = blockIdx.x * 512 + threadIdx.x; e < (64 + 32 + 8) * 128; e += gridDim.x * 512) {
        const int i = e & 127, r = e >> 7;
        const double inv = exp(-((double)i / 127.0) * 9.210340371976184);
        const double pos = r < 64 ? (double)r : r < 96 ? (double)((r - 64) * 64) : (double)(16384 + (r - 96));
        double sn, cs; sincos(pos * inv, &sn, &cs);
        f32x2* dst = (f32x2*)(p.ws + (r < 64 ? WS_TABR : r < 96 ? WS_TABC : WS_TABS)) + ((r < 64 ? r : r < 96 ? r - 64 : r - 96) * 128 + i);
        *dst = (f32x2){(float)cs, (float)sn};
    }
}

DI void phase_gdn_prep(const Params& p, unsigned char* smem) {
    float* ks = (float*)smem;
    float* vs = ks + 64 * 132;
    float* lowT = vs + 64 * 132;
    float* Gs = lowT + 64 * 68;
    float* Bs = Gs + 64;
    float* Es = Bs + 64;
    float* qs = Es + 64 + 64;
    float* solL = qs;
    const bf16_t* P0 = (const bf16_t*)(p.ws + WS_P0);
    const int tid = opaque_tid(), lane = tid & 63, wid = tid >> 6, hh = lane >> 5, l31 = lane & 31;
    for (int e = blockIdx.x * 512 + tid; e < (8 + 128) * 3 * 3072; e += gridDim.x * 512) {
        const int ch = e % 3072, r = (e / 3072) % 3, b = e / 9216;
        if (b < 8) p.out[O_GCP + (size_t)(b * 3 + r) * 3072 + ch] = bf2f(P0[(size_t)(b * 2048 + 2045 + r) * LDP0 + ch]);
        else { const int bb = b - 8; p.out[O_GCS + (size_t)(bb * 3 + r) * 3072 + ch] = bf2f(P0[(size_t)(T_PR + bb * 8 + 5 + r) * LDP0 + ch]); }
    }
    const int a_rg = tid / 96, a_cq = tid - a_rg * 96, a_sec = a_cq >> 5, a_c4 = (a_cq & 31) * 4, a_r0 = a_rg * 13;
    u32x2 xv[16];
#define GDN_LOAD_ROWS(it) do { const int n_ = (it) & 31, h_ = ((it) >> 5) & 7, b_ = (it) >> 8, col_ = a_sec * 1024 + h_ * 128 + a_c4; \
        _Pragma("unroll") for (int r = 0; r < 16; ++r) { const int rr = a_r0 + r - 3, tr = n_ * 64 + rr; \
            xv[r] = (a_rg < 5 && rr < 64 && tr >= 0) ? *(const u32x2*)(P0 + (size_t)(b_ * 2048 + tr) * LDP0 + col_) : (u32x2){0u, 0u}; } } while (0)
    if ((int)blockIdx.x < 2048) GDN_LOAD_ROWS((int)blockIdx.x);
    for (int item = blockIdx.x; item < 2048; item += gridDim.x) {
        const int n = item & 31, h = (item >> 5) & 7, b = item >> 8;
        const int tok0 = b * 2048 + n * 64;
        unsigned char* blk = p.ws + WS_GOP + (size_t)item * GOP_STRIDE;
        int tid_i = tid; asm volatile("" : "+v"(tid_i));
        const int tid = tid_i, lane = tid & 63, wid = tid >> 6, hh = lane >> 5, l31 = lane & 31;
        float braw = 0.f, araw = 0.f;
        if (wid == 0) { braw = bf2f(P0[(size_t)(tok0 + lane) * LDP0 + 4096 + h]); araw = bf2f(P0[(size_t)(tok0 + lane) * LDP0 + 4104 + h]); }
        bf16_t* o_nw = (bf16_t*)blk; bf16_t* o_qe = o_nw + 8192; bf16_t* o_kdT = o_qe + 8192; bf16_t* o_qkd = o_kdT + 8192; bf16_t* o_u0T = o_qkd + 4096;
        _Pragma("unroll") for (int rpA = 0; rpA <= ((PROBE_MASK >> 19) & 1); ++rpA)
        {
            const int rg = a_rg, sec = a_sec, c4 = a_c4, col = sec * 1024 + h * 128 + c4, r0 = a_r0;
            f32x4 w[4];
#pragma unroll
            for (int j = 0; j < 4; ++j) w[j] = *(const f32x4*)(p.conv_w + j * 3072 + col);
            float* dstb = (sec == 0 ? qs : sec == 1 ? ks : vs) + c4;
#pragma unroll
            for (int r = 0; r < 13; ++r) {
                float o0 = 0.f, o1 = 0.f, o2 = 0.f, o3 = 0.f;
#pragma unroll
                for (int j = 0; j < 4; ++j) { o0 += bflo(xv[r + j].x) * w[j].x; o1 += bfhi(xv[r + j].x) * w[j].y; o2 += bflo(xv[r + j].y) * w[j].z; o3 += bfhi(xv[r + j].y) * w[j].w; }
                o0 = silu_f(o0); o1 = silu_f(o1); o2 = silu_f(o2); o3 = silu_f(o3);
                float ss = row16_sum(o0 * o0 + o1 * o1 + o2 * o2 + o3 * o3);
                ss += __shfl_xor(ss, 16);
                float sc = 1.f;
                if (sec < 2) sc = rsqrtf(ss + 1e-6f) * (sec == 0 ? 0.08838834764831845f : 1.f);
                if (rg < 5 && r0 + r < 64) *(f32x4*)(dstb + (r0 + r) * 132) = (f32x4){o0 * sc, o1 * sc, o2 * sc, o3 * sc};
            }
        }
        if (wid == 0) {
            const float beta = 1.f / (1.f + expf(-braw));
            const float xx = araw + p.dt_bias[h];
            const float sp = xx > 20.f ? xx : log1pf(expf(xx));
            float g = -expf(p.a_log[h]) * sp;
#pragma unroll
            for (int d = 1; d < 64; d <<= 1) { const float t = __shfl_up(g, d); if (lane >= d) g += t; }
            Gs[lane] = g; Bs[lane] = beta; Es[lane] = expf(g);
        }
        lds_barrier();
        _Pragma("unroll") for (int rpC = 0; rpC <= ((PROBE_MASK >> 20) & 1); ++rpC) {
            const int which = wid >> 2, ti = (wid >> 1) & 1, tj = wid & 1;
            const float* Ap = (which ? qs : ks) + (32 * ti + l31) * 132 + 8 * hh;
            const float* Bp = ks + (32 * tj + l31) * 132 + 8 * hh;
            f32x16 acc;
#pragma unroll
            for (int i = 0; i < 16; ++i) acc[i] = 0.f;
            if (ti >= tj) {
#pragma unroll 2
                for (int k0 = 0; k0 < 128; k0 += 16) {
                    bf16x8 ah, al, bh, bl;
                    split8(*(const f32x4*)(Ap + k0), *(const f32x4*)(Ap + k0 + 4), ah, al);
                    split8(*(const f32x4*)(Bp + k0), *(const f32x4*)(Bp + k0 + 4), bh, bl);
                    acc = MFMA32(ah, bh, acc);
                    if (which == 0) { acc = MFMA32(ah, bl, acc); acc = MFMA32(al, bh, acc); }
                }
            }
            const int col = 32 * tj + l31; const float Gc = Gs[col];
#pragma unroll
            for (int i = 0; i < 16; ++i) {
                const int row = 32 * ti + crow(i, hh);
                const float dec = __expf(fminf(Gs[row] - Gc, 0.f));
                if (which == 0) lowT[col * 68 + row] = row > col ? Bs[row] * acc[i] * dec : 0.f;
                else { const int kk = col & 15; o_qkd[((((row >> 5) * 4 + (col >> 4)) * 64 + (row & 31) + 32 * ((kk >> 2) & 1)) << 3) + (kk & 3) + 4 * (kk >> 3)] = f2bf(row >= col ? acc[i] * dec : 0.f); }
            }
        }
        lds_barrier();
#pragma unroll
        for (int m = 0; m < 2; ++m) { const int e = tid + 512 * m, i = e >> 4, d0 = (e & 15) * 8; const float eg = Es[i]; const float* s = qs + i * 132 + d0;
            u32x2 w0, w1; w0.x = pk_bf16(s[0] * eg, s[1] * eg); w0.y = pk_bf16(s[2] * eg, s[3] * eg); w1.x = pk_bf16(s[4] * eg, s[5] * eg); w1.y = pk_bf16(s[6] * eg, s[7] * eg);
            bf16_t* fp = o_qe + ((((i >> 5) * 8 + (d0 >> 4)) * 64 + (i & 31)) << 3) + ((d0 >> 3) & 1) * 4;
            *(u32x2*)fp = w0; *(u32x2*)(fp + 32 * 8) = w1; }
        { const float GL = Gs[63];
#pragma unroll
          for (int m = 0; m < 2; ++m) { const int e = tid + 512 * m, d = e & 127, i0 = (e >> 7) * 8; float v[8];
#pragma unroll
            for (int j = 0; j < 8; ++j) v[j] = ks[(i0 + j) * 132 + d] * __expf(GL - Gs[i0 + j]);
            u32x2 w0, w1; w0.x = pk_bf16(v[0], v[1]); w0.y = pk_bf16(v[2], v[3]); w1.x = pk_bf16(v[4], v[5]); w1.y = pk_bf16(v[6], v[7]);
            bf16_t* fp = o_kdT + ((((d >> 5) * 4 + (i0 >> 4)) * 64 + (d & 31)) << 3) + ((i0 >> 3) & 1) * 4;
            *(u32x2*)fp = w0; *(u32x2*)(fp + 32 * 8) = w1; }
          if (tid == 0) *(float*)(blk + 73728) = expf(GL); }
        if (item + (int)gridDim.x < 2048) GDN_LOAD_ROWS(item + (int)gridDim.x);
        lds_barrier();
        _Pragma("unroll") for (int rpE = 0; rpE <= ((PROBE_MASK >> 18) & 1); ++rpE)
        {
            const int isk = wid >> 2, sl = wid & 3, c0 = sl * 32 + l31;
            const float* src = (isk ? ks : vs) + c0;
            f32x16 R[2];
#pragma unroll
            for (int rt = 0; rt < 2; ++rt)
#pragma unroll
                for (int i = 0; i < 16; ++i) { const int row = 32 * rt + crow(i, hh); R[rt][i] = Bs[row] * src[row * 132] * (isk ? Es[row] : 1.f); }
#pragma unroll
            for (int bI = 0; bI < 8; ++bI) {
                const int rt = bI >> 2, g = bI & 3;
                const int rA = 8 * bI + 4 * hh, rP = 8 * bI + 4 * (1 - hh);
                const float* tp = lowT + rA * 68 + rA;
                const float t10 = tp[1], t20 = tp[2], t30 = tp[3], t21 = tp[68 + 2], t31 = tp[68 + 3], t32 = tp[136 + 3];
                float a0 = R[rt][4 * g], a1 = R[rt][4 * g + 1], a2 = R[rt][4 * g + 2], a3 = R[rt][4 * g + 3];
                float x0 = a0, x1 = a1 - t10 * x0, x2 = a2 - t20 * x0 - t21 * x1, x3 = a3 - t30 * x0 - t31 * x1 - t32 * x2;
                const float y0 = __shfl_xor(x0, 32), y1 = __shfl_xor(x1, 32), y2 = __shfl_xor(x2, 32), y3 = __shfl_xor(x3, 32);
                const float* cq = lowT + rP * 68 + rA;
                a0 -= cq[0] * y0 + cq[68] * y1 + cq[136] * y2 + cq[204] * y3;
                a1 -= cq[1] * y0 + cq[68 + 1] * y1 + cq[136 + 1] * y2 + cq[204 + 1] * y3;
                a2 -= cq[2] * y0 + cq[68 + 2] * y1 + cq[136 + 2] * y2 + cq[204 + 2] * y3;
                a3 -= cq[3] * y0 + cq[68 + 3] * y1 + cq[136 + 3] * y2 + cq[204 + 3] * y3;
                x0 = a0; x1 = a1 - t10 * x0; x2 = a2 - t20 * x0 - t21 * x1; x3 = a3 - t30 * x0 - t31 * x1 - t32 * x2;
                if (isk) {
                    const int kk = c0 & 15; const float xs4[4] = {x0, x1, x2, x3};
#pragma unroll
                    for (int a = 0; a < 4; ++a) { const int row = rA + a;
                        o_nw[((((row >> 5) * 8 + (c0 >> 4)) * 64 + (row & 31) + 32 * ((kk >> 2) & 1)) << 3) + (kk & 3) + 4 * (kk >> 3)] = f2bf(-xs4[a]); }
                } else {
                    u32x2 w0; w0.x = pk_bf16(x0, x1); w0.y = pk_bf16(x2, x3);
                    *(u32x2*)(o_u0T + ((((sl * 2 + rt) * 64 + lane) << 4) + 4 * g)) = w0;
                }
                bf16x8 xh, xl; split4z(-x0, -x1, -x2, -x3, xh, xl);
#pragma unroll
                for (int rt2 = rt; rt2 < 2; ++rt2) {
                    if (rt2 == rt && g == 3) continue;
                    const float* ap = lowT + rA * 68 + 32 * rt2 + l31;
                    bf16x8 ah, al; split4z(ap[0], ap[68], ap[136], ap[204], ah, al);
                    R[rt2] = MFMA32(ah, xh, R[rt2]); R[rt2] = MFMA32(ah, xl, R[rt2]); R[rt2] = MFMA32(al, xh, R[rt2]);
                }
                __builtin_amdgcn_sched_barrier(0);
            }
        }
        lds_barrier();
    }
}

#define LDSV(off) (*(const LAS bf16x8*)(base + (off)))
DI void gdn_scan_prompt(const Params& p, int bh, unsigned char* smem) {
    LAS unsigned char* lds = (LAS unsigned char*)smem;
    const int tid = opaque_tid(), lane = tid & 63, wid = __builtin_amdgcn_readfirstlane(tid >> 6), hh = lane >> 5, l31 = lane & 31;
    const int h = bh & 7, b = bh >> 3, s = wid;
    const unsigned char* gblk = p.ws + WS_GOP + (size_t)bh * 32 * GOP_STRIDE;
    bf16_t* oraw = (bf16_t*)(p.ws + WS_ORAW);
    f32x16 S[4];
#pragma unroll
    for (int t = 0; t < 4; ++t)
#pragma unroll
        for (int i = 0; i < 16; ++i) S[t][i] = 0.f;
    unsigned voff16 = lane * 16; asm volatile("" : "+v"(voff16));
#define GDN_DMA(n, buf) do { const unsigned char* g_ = gblk + (size_t)(n) * GOP_STRIDE; _Pragma("unroll") for (int i_ = 0; i_ < 18; ++i_) { const int pc_ = (wid - 4) + 4 * i_; \
        __builtin_amdgcn_global_load_lds((const unsigned*)((g_ + pc_ * 1024) + voff16), (LAS unsigned*)(lds + (buf) * 73728 + pc_ * 1024), 16, 0, 0); } } while (0)
#define GDN_BAR() do { asm volatile("" ::: "memory"); __builtin_amdgcn_s_barrier(); asm volatile("" ::: "memory"); } while (0)
    lds_barrier();
#define GDN_PF(n) do { const unsigned char* g_ = gblk + (size_t)(n) * GOP_STRIDE; _Pragma("unroll") for (int i_ = 0; i_ < 18; ++i_) { const int pc_ = (wid - 4) + 4 * i_; \
        __builtin_amdgcn_global_load_lds((const unsigned*)((g_ + pc_ * 1024) + voff16), (LAS unsigned*)(lds + 148480 + (wid - 4) * 1024), 16, 0, 0); } } while (0)
    if (wid >= 4) { GDN_DMA(0, 0); GDN_PF(1); GDN_PF(2); asm volatile("s_waitcnt vmcnt(0)" ::: "memory"); }
    GDN_BAR();
    for (int n = 0; n < 32; ++n) {
        if (wid >= 4 && n + 1 < 32) GDN_DMA(n + 1, (n + 1) & 1);
        if (wid >= 4 && n + 3 < 32) GDN_PF(n + 3);
        if (wid < 4) {
            LAS unsigned char* base = lds + (n & 1) * 73728 + lane * 16;
            const float dl = *(const float*)(gblk + (size_t)n * GOP_STRIDE + 73728);
            bf16x8 Ub[4];
            {
                f32x16 U[2];
#pragma unroll
                for (int rt = 0; rt < 2; ++rt) {
#pragma unroll
                    for (int g = 0; g < 2; ++g) { const u32x4 v = *(const LAS u32x4*)(lds + (n & 1) * 73728 + 57344 + (((s * 2 + rt) * 64 + lane) << 5) + 16 * g);
                        U[rt][8 * g] = bflo(v.x); U[rt][8 * g + 1] = bfhi(v.x); U[rt][8 * g + 2] = bflo(v.y); U[rt][8 * g + 3] = bfhi(v.y);
                        U[rt][8 * g + 4] = bflo(v.z); U[rt][8 * g + 5] = bfhi(v.z); U[rt][8 * g + 6] = bflo(v.w); U[rt][8 * g + 7] = bfhi(v.w); }
                }
#pragma unroll
                for (int t = 0; t < 4; ++t)
#pragma unroll
                    for (int s2 = 0; s2 < 2; ++s2) {
                        const bf16x8 sb = packB(S[t], s2);
#pragma unroll
                        for (int rt = 0; rt < 2; ++rt) U[rt] = MFMA32(LDSV((rt * 8 + 2 * t + s2) * 1024), sb, U[rt]);
                    }
#pragma unroll
                for (int kc = 0; kc < 4; ++kc) Ub[kc] = packB(U[kc >> 1], kc & 1);
            }
            f32x16 O[2];
#pragma unroll
            for (int rt = 0; rt < 2; ++rt)
#pragma unroll
                for (int i = 0; i < 16; ++i) O[rt][i] = 0.f;
#pragma unroll
            for (int t = 0; t < 4; ++t)
#pragma unroll
                for (int s2 = 0; s2 < 2; ++s2) {
                    const bf16x8 sb = packB(S[t], s2);
#pragma unroll
                    for (int rt = 0; rt < 2; ++rt) O[rt] = MFMA32(LDSV(16384 + (rt * 8 + 2 * t + s2) * 1024), sb, O[rt]);
                }
#pragma unroll
            for (int rt = 0; rt < 2; ++rt)
#pragma unroll
                for (int kc = 0; kc < 2 * rt + 2; ++kc) O[rt] = MFMA32(LDSV(49152 + (rt * 4 + kc) * 1024), Ub[kc], O[rt]);
            const size_t tok0 = (size_t)b * 2048 + n * 64;
#pragma unroll
            for (int rt = 0; rt < 2; ++rt)
#pragma unroll
                for (int i = 0; i < 16; ++i) oraw[(tok0 + 32 * rt + crow(i, hh)) * 1024 + h * 128 + 32 * s + l31] = f2bf(O[rt][i]);
#pragma unroll
            for (int t = 0; t < 4; ++t) {
#pragma unroll
                for (int i = 0; i < 16; ++i) S[t][i] *= dl;
#pragma unroll
                for (int kc = 0; kc < 4; ++kc) S[t] = MFMA32(LDSV(32768 + (t * 4 + kc) * 1024), Ub[kc], S[t]);
            }
        }
        if (wid >= 4) { if (n + 3 < 32) asm volatile("s_waitcnt vmcnt(18)" ::: "memory"); else asm volatile("s_waitcnt vmcnt(0)" ::: "memory"); }
        else asm volatile("s_waitcnt lgkmcnt(0)" ::: "memory");
        GDN_BAR();
    }
    lds_barrier();
#undef GDN_BAR
#undef GDN_PF
#undef GDN_DMA
    if (wid < 4) {
        float* so = p.out + O_GSP + (size_t)bh * 16384;
#pragma unroll
        for (int t = 0; t < 4; ++t)
#pragma unroll
            for (int i = 0; i < 16; ++i) so[(32 * t + crow(i, hh)) * 128 + 32 * s + l31] = S[t][i];
    }
}

DI void gdn_sample_item(const Params& p, int item, unsigned char* smem) {
    float* raw = (float*)smem;
    float* nwT = raw + 3072;
    float* qeT = nwT + 1024;
    float* kdT = qeT + 1024;
    float* u0 = kdT + 1024;
    float* lowm = u0 + 1024;
    float* qkm = lowm + 64;
    float* Gs = qkm + 64;
    float* part = Gs + 32;
    const bf16_t* P0 = (const bf16_t*)(p.ws + WS_P0);
    int tid_ = threadIdx.x; asm volatile("" : "+v"(tid_));
    const int tid = tid_, lane = tid & 63, wid = tid >> 6;
    const int h = item & 7, b = item >> 3, tok0 = T_PR + b * 8;
#pragma unroll
    for (int m = 0; m < 6; ++m) {
        const int e = tid + 512 * m, row = e / 384, c3 = e - row * 384, sec = c3 >> 7, col = sec * 1024 + h * 128 + (c3 & 127);
        float o = 0.f;
#pragma unroll
        for (int j = 0; j < 4; ++j) { const int tr = row - 3 + j;
            const float x = tr >= 0 ? bf2f(P0[(size_t)(tok0 + tr) * LDP0 + col]) : p.st_conv[(size_t)(b * 3 + (3 + tr)) * 3072 + col];
            o += x * p.conv_w[j * 3072 + col]; }
        raw[sec * 1024 + row * 128 + (c3 & 127)] = silu_f(o);
    }
    if (tid < 8) {
        const float braw = bf2f(P0[(size_t)(tok0 + tid) * LDP0 + 4096 + h]), araw = bf2f(P0[(size_t)(tok0 + tid) * LDP0 + 4104 + h]);
        const float xx = araw + p.dt_bias[h]; const float sp = xx > 20.f ? xx : log1pf(expf(xx));
        Gs[16 + tid] = -expf(p.a_log[h]) * sp;
        Gs[8 + tid] = 1.f / (1.f + expf(-braw));
    }
    lds_barrier();
    { float q0 = raw[wid * 128 + lane], q1 = raw[wid * 128 + 64 + lane], k0 = raw[1024 + wid * 128 + lane], k1 = raw[1024 + wid * 128 + 64 + lane];
      const float sq = wave_sum(q0 * q0 + q1 * q1), sk = wave_sum(k0 * k0 + k1 * k1);
      const float cq = rsqrtf(sq + 1e-6f) * 0.08838834764831845f, ck = rsqrtf(sk + 1e-6f);
      raw[wid * 128 + lane] = q0 * cq; raw[wid * 128 + 64 + lane] = q1 * cq; raw[1024 + wid * 128 + lane] = k0 * ck; raw[1024 + wid * 128 + 64 + lane] = k1 * ck; }
    if (tid == 0) { float a = 0.f; for (int i = 0; i < 8; ++i) { a += Gs[16 + i]; Gs[i] = a; } }
    lds_barrier();
    if (tid < 8) Gs[24 + tid] = expf(Gs[tid]);
    { const int i = wid; const float ki0 = raw[1024 + i * 128 + lane], ki1 = raw[1024 + i * 128 + 64 + lane], qi0 = raw[i * 128 + lane], qi1 = raw[i * 128 + 64 + lane];
      for (int j = 0; j <= i; ++j) { const float kj0 = raw[1024 + j * 128 + lane], kj1 = raw[1024 + j * 128 + 64 + lane];
          const float kk = wave_sum(ki0 * kj0 + ki1 * kj1), qk = wave_sum(qi0 * kj0 + qi1 * kj1);
          const float dec = expf(Gs[i] - Gs[j]);
          if (lane == 0) { lowm[i * 8 + j] = (j < i) ? Gs[8 + i] * kk * dec : 0.f; qkm[i * 8 + j] = qk * dec; } } }
    lds_barrier();
    if (tid < 256) {
        const int isk = tid >> 7, cc = tid & 127; float sol[8];
#pragma unroll
        for (int i = 0; i < 8; ++i) { float r = Gs[8 + i] * (isk ? Gs[24 + i] * raw[1024 + i * 128 + cc] : raw[2048 + i * 128 + cc]);
#pragma unroll
            for (int j = 0; j < i; ++j) r -= lowm[i * 8 + j] * sol[j];
            sol[i] = r; }
#pragma unroll
        for (int i = 0; i < 8; ++i) { if (isk) nwT[cc * 8 + i] = -sol[i]; else u0[i * 128 + cc] = sol[i]; }
    } else {
        const int t2 = tid - 256, which = t2 >> 7, d = t2 & 127;
#pragma unroll
        for (int i = 0; i < 8; ++i) { if (which == 0) qeT[d * 8 + i] = raw[i * 128 + d] * Gs[24 + i]; else kdT[d * 8 + i] = raw[1024 + i * 128 + d] * expf(Gs[7] - Gs[i]); }
    }
    lds_barrier();
    const int dv = tid & 127, qt = tid >> 7;
    const float* S0 = p.st_gdn + (size_t)item * 16384;
    float pu[8], po[8];
#pragma unroll
    for (int c = 0; c < 8; ++c) { pu[c] = 0.f; po[c] = 0.f; }
#pragma unroll 1
    for (int r0 = 0; r0 < 32; r0 += 16) {
        float sv[16];
#pragma unroll
        for (int r = 0; r < 16; ++r) sv[r] = S0[(32 * qt + r0 + r) * 128 + dv];
#pragma unroll
        for (int r = 0; r < 16; ++r) { const int dk = 32 * qt + r0 + r;
            const f32x4 w0 = *(const f32x4*)(nwT + dk * 8), w1 = *(const f32x4*)(nwT + dk * 8 + 4), e0 = *(const f32x4*)(qeT + dk * 8), e1 = *(const f32x4*)(qeT + dk * 8 + 4);
            const float s = sv[r];
            pu[0] += w0.x * s; pu[1] += w0.y * s; pu[2] += w0.z * s; pu[3] += w0.w * s; pu[4] += w1.x * s; pu[5] += w1.y * s; pu[6] += w1.z * s; pu[7] += w1.w * s;
            po[0] += e0.x * s; po[1] += e0.y * s; po[2] += e0.z * s; po[3] += e0.w * s; po[4] += e1.x * s; po[5] += e1.y * s; po[6] += e1.z * s; po[7] += e1.w * s; }
    }
#pragma unroll
    for (int c = 0; c < 8; ++c) { part[(qt * 8 + c) * 128 + dv] = pu[c]; part[4096 + (qt * 8 + c) * 128 + dv] = po[c]; }
    lds_barrier();
    float u[8];
#pragma unroll
    for (int c = 0; c < 8; ++c) u[c] = u0[c * 128 + dv] + part[c * 128 + dv] + part[(8 + c) * 128 + dv] + part[(16 + c) * 128 + dv] + part[(24 + c) * 128 + dv];
    if (qt == 0) {
        bf16_t* oraw = (bf16_t*)(p.ws + WS_ORAW);
#pragma unroll
        for (int c = 0; c < 8; ++c) { float o = part[4096 + c * 128 + dv] + part[4096 + (8 + c) * 128 + dv] + part[4096 + (16 + c) * 128 + dv] + part[4096 + (24 + c) * 128 + dv];
#pragma unroll
            for (int j = 0; j <= c; ++j) o += qkm[c * 8 + j] * u[j];
            oraw[(size_t)(tok0 + c) * 1024 + h * 128 + dv] = f2bf(o); }
    }
    { const float dl = Gs[24 + 7]; float* So = p.out + O_GSS + (size_t)item * 16384;
#pragma unroll 1
      for (int r0 = 0; r0 < 32; r0 += 16) {
          float sv[16];
#pragma unroll
          for (int r = 0; r < 16; ++r) sv[r] = S0[(32 * qt + r0 + r) * 128 + dv];
#pragma unroll
          for (int r = 0; r < 16; ++r) { const int dk = 32 * qt + r0 + r; const f32x4 k0 = *(const f32x4*)(kdT + dk * 8), k1 = *(const f32x4*)(kdT + dk * 8 + 4);
              So[dk * 128 + dv] = dl * sv[r] + k0.x * u[0] + k0.y * u[1] + k0.z * u[2] + k0.w * u[3] + k1.x * u[4] + k1.y * u[5] + k1.z * u[6] + k1.w * u[7]; }
      } }
    lds_barrier();
}
DI void phase_gdn_scan(const Params& p, unsigned char* smem) {
    const int nscan = 64;
    if ((int)blockIdx.x < nscan) {
        _Pragma("unroll") for (int rp = 0; rp <= ((PROBE_MASK >> 13) & 1); ++rp)
        for (int bh = blockIdx.x; bh < 64; bh += nscan) gdn_scan_prompt(p, bh, smem);
    } else {
        _Pragma("unroll") for (int rp = 0; rp <= ((PROBE_MASK >> 14) & 1); ++rp)
        for (int item = blockIdx.x - nscan; item < 1024; item += gridDim.x - nscan) gdn_sample_item(p, item, smem);
    }
}

DI void phase_gdn_gate(const Params& p) {
    const int lane = threadIdx.x & 63, gw = blockIdx.x * 8 + (threadIdx.x >> 6), nw = gridDim.x * 8;
    const bf16_t* oraw = (const bf16_t*)(p.ws + WS_ORAW); const bf16_t* P0 = (const bf16_t*)(p.ws + WS_P0); bf16_t* og = (bf16_t*)(p.ws + WS_OG);
    for (int tok = gw; tok < T_TOK; tok += nw) {
        const u32x4 a0 = *(const u32x4*)(oraw + (size_t)tok * 1024 + 16 * lane), a1 = *(const u32x4*)(oraw + (size_t)tok * 1024 + 16 * lane + 8);
        const u32x4 z0 = *(const u32x4*)(P0 + (size_t)tok * LDP0 + 3072 + 16 * lane), z1 = *(const u32x4*)(P0 + (size_t)tok * LDP0 + 3072 + 16 * lane + 8);
        float o[16], z[16];
        const unsigned au[8] = {a0.x, a0.y, a0.z, a0.w, a1.x, a1.y, a1.z, a1.w}, zu[8] = {z0.x, z0.y, z0.z, z0.w, z1.x, z1.y, z1.z, z1.w};
        float ss = 0.f;
#pragma unroll
        for (int i = 0; i < 8; ++i) { o[2 * i] = bflo(au[i]); o[2 * i + 1] = bfhi(au[i]); z[2 * i] = bflo(zu[i]); z[2 * i + 1] = bfhi(zu[i]); ss += o[2 * i] * o[2 * i] + o[2 * i + 1] * o[2 * i + 1]; }
        ss += __shfl_xor(ss, 1); ss += __shfl_xor(ss, 2); ss += __shfl_xor(ss, 4);
        const float rstd = rsqrtf(ss * (1.f / 128.f) + 1e-6f);
        const int d0 = (16 * lane) & 127;
        unsigned r[8];
#pragma unroll
        for (int i = 0; i < 8; ++i) { const float v0 = o[2 * i] * rstd * p.onorm_a[d0 + 2 * i] * silu_f(z[2 * i]), v1 = o[2 * i + 1] * rstd * p.onorm_a[d0 + 2 * i + 1] * silu_f(z[2 * i + 1]); r[i] = pk_bf16(v0, v1); }
        *(u32x4*)(og + (size_t)tok * 1024 + 16 * lane) = (u32x4){r[0], r[1], r[2], r[3]};
        *(u32x4*)(og + (size_t)tok * 1024 + 16 * lane + 8) = (u32x4){r[4], r[5], r[6], r[7]};
    }
}

DI float ret_lg(int h) { return log1pf(-exp2f(-5.f - (float)h)); }
DI void rot_angle(double pos, double inv, float& sn, float& cs) {
    const double rev = pos * inv * 0.15915494309189535; const float fr = (float)(rev - rint(rev));
    sincosf(fr * 6.283185307179586f, &sn, &cs);
}
DI void phase_ret_prep(const Params& p, unsigned char* smem) {
    bf16_t* qr = (bf16_t*)smem;
    bf16_t* kr = qr + 64 * 264;
    bf16_t* vs = kr + 64 * 264;
    const bf16_t* P1 = (const bf16_t*)(p.ws + WS_P1);
    const f32x2* tabR = (const f32x2*)(p.ws + WS_TABR); const f32x2* tabC = (const f32x2*)(p.ws + WS_TABC);
    const int tid = opaque_tid(), lane = tid & 63, wid = tid >> 6, hh = lane >> 5, l31 = lane & 31;
    for (int item = blockIdx.x; item < 1024; item += gridDim.x) {
        const int n = item & 31, h = (item >> 5) & 3, b = item >> 7;
        const int tok0 = b * 2048 + n * 64;
        const float lg = ret_lg(h);
        unsigned char* blk = p.ws + WS_ROP + (size_t)item * ROP_STRIDE;
        bf16_t* o_qd = (bf16_t*)blk; bf16_t* o_kdT = o_qd + 16384; bf16_t* o_qkD = o_kdT + 16384; bf16_t* o_vT = o_qkD + 4096;
#pragma unroll
        for (int m = 0; m < 2; ++m) {
            const int e = tid + 512 * m, row = e >> 4, i0 = (e & 15) * 8;
            const bf16_t* src = P1 + (size_t)(tok0 + row) * LDP1 + h * 256 + i0;
            const u32x4 q1 = *(const u32x4*)src, q2 = *(const u32x4*)(src + 128), k1 = *(const u32x4*)(src + 1024), k2 = *(const u32x4*)(src + 1152);
            const unsigned q1u[4] = {q1.x, q1.y, q1.z, q1.w}, q2u[4] = {q2.x, q2.y, q2.z, q2.w}, k1u[4] = {k1.x, k1.y, k1.z, k1.w}, k2u[4] = {k2.x, k2.y, k2.z, k2.w};
            float qa[8], qb[8], ka[8], kb[8];
#pragma unroll
            for (int j = 0; j < 8; ++j) {
                const f32x2 tr = tabR[row * 128 + i0 + j], tc = tabC[n * 128 + i0 + j];
                const float cs = tc.x * tr.x - tc.y * tr.y, sn = tc.y * tr.x + tc.x * tr.y;
                const float x1 = (j & 1) ? bfhi(q1u[j >> 1]) : bflo(q1u[j >> 1]), x2 = (j & 1) ? bfhi(q2u[j >> 1]) : bflo(q2u[j >> 1]);
                const float y1 = (j & 1) ? bfhi(k1u[j >> 1]) : bflo(k1u[j >> 1]), y2 = (j & 1) ? bfhi(k2u[j >> 1]) : bflo(k2u[j >> 1]);
                qa[j] = x1 * cs - x2 * sn; qb[j] = x1 * sn + x2 * cs;
                ka[j] = (y1 * cs - y2 * sn) * 0.0625f; kb[j] = (y1 * sn + y2 * cs) * 0.0625f;
            }
            const float qdec = expf(lg * (float)(row + 1));
            u32x4 w;
            w.x = pk_bf16(qa[0], qa[1]); w.y = pk_bf16(qa[2], qa[3]); w.z = pk_bf16(qa[4], qa[5]); w.w = pk_bf16(qa[6], qa[7]); *(u32x4*)(qr + row * 264 + i0) = w;
            w.x = pk_bf16(qb[0], qb[1]); w.y = pk_bf16(qb[2], qb[3]); w.z = pk_bf16(qb[4], qb[5]); w.w = pk_bf16(qb[6], qb[7]); *(u32x4*)(qr + row * 264 + 128 + i0) = w;
            w.x = pk_bf16(ka[0], ka[1]); w.y = pk_bf16(ka[2], ka[3]); w.z = pk_bf16(ka[4], ka[5]); w.w = pk_bf16(ka[6], ka[7]); *(u32x4*)(kr + row * 264 + i0) = w;
            w.x = pk_bf16(kb[0], kb[1]); w.y = pk_bf16(kb[2], kb[3]); w.z = pk_bf16(kb[4], kb[5]); w.w = pk_bf16(kb[6], kb[7]); *(u32x4*)(kr + row * 264 + 128 + i0) = w;
            { u32x2 w0, w1; bf16_t* fp = o_qd + ((((row >> 5) * 16 + (i0 >> 4)) * 64 + (row & 31)) << 3) + ((i0 >> 3) & 1) * 4;
              w0.x = pk_bf16(qa[0] * qdec, qa[1] * qdec); w0.y = pk_bf16(qa[2] * qdec, qa[3] * qdec); w1.x = pk_bf16(qa[4] * qdec, qa[5] * qdec); w1.y = pk_bf16(qa[6] * qdec, qa[7] * qdec);
              *(u32x2*)fp = w0; *(u32x2*)(fp + 32 * 8) = w1;
              w0.x = pk_bf16(qb[0] * qdec, qb[1] * qdec); w0.y = pk_bf16(qb[2] * qdec, qb[3] * qdec); w1.x = pk_bf16(qb[4] * qdec, qb[5] * qdec); w1.y = pk_bf16(qb[6] * qdec, qb[7] * qdec);
              *(u32x2*)(fp + 8 * 64 * 8) = w0; *(u32x2*)(fp + 8 * 64 * 8 + 32 * 8) = w1; }
        }
        lds_barrier();
        if (wid < 4) {
            const int ti = wid >> 1, tj = wid & 1;
            f32x16 acc;
#pragma unroll
            for (int i = 0; i < 16; ++i) acc[i] = 0.f;
            if (ti >= tj) {
#pragma unroll 4
                for (int ksp = 0; ksp < 16; ++ksp)
                    acc = MFMA32(ld16(qr + (32 * ti + l31) * 264 + 16 * ksp + 8 * hh), ld16(kr + (32 * tj + l31) * 264 + 16 * ksp + 8 * hh), acc);
            }
            const int col = 32 * tj + l31;
#pragma unroll
            for (int i = 0; i < 16; ++i) { const int row = 32 * ti + crow(i, hh);
                o_qkD[((((row >> 5) * 4 + (col >> 4)) * 64 + (row & 31) + 32 * ((col >> 3) & 1)) << 3) + (col & 7)] = f2bf(row >= col ? acc[i] * __expf(lg * (float)(row - col)) : 0.f); }
        } else {
            const int dk = tid - 256;
#pragma unroll
            for (int i0 = 0; i0 < 64; i0 += 8) { float v[8];
#pragma unroll
                for (int j = 0; j < 8; ++j) v[j] = bf2f(kr[(i0 + j) * 264 + dk]) * __expf(lg * (float)(63 - i0 - j));
                u32x4 w; w.x = pk_bf16(v[0], v[1]); w.y = pk_bf16(v[2], v[3]); w.z = pk_bf16(v[4], v[5]); w.w = pk_bf16(v[6], v[7]);
                *(u32x4*)(o_kdT + ((((dk >> 5) * 4 + (i0 >> 4)) * 64 + (dk & 31) + 32 * ((i0 >> 3) & 1)) << 3)) = w; }
        }
        lds_barrier();
    }
}

DI void ret_scan_prompt(const Params& p, int item, unsigned char* smem) {
    LAS unsigned char* lds = (LAS unsigned char*)smem;
    const int tid = opaque_tid(), lane = tid & 63, wid = __builtin_amdgcn_readfirstlane(tid >> 6), hh = lane >> 5, l31 = lane & 31;
    const int half = item & 1, bh = item >> 1, h = bh & 3, b = bh >> 2, s = half * 8 + wid;
    const float sdec = expf(ret_lg(h) * 64.f);
    const unsigned char* gblk = p.ws + WS_ROP + (size_t)bh * 32 * ROP_STRIDE;
    bf16_t* oraw = (bf16_t*)(p.ws + WS_ORAW);
    LAS unsigned char* base = lds + lane * 16;
    f32x16 S[8];
#pragma unroll
    for (int t = 0; t < 8; ++t)
#pragma unroll
        for (int i = 0; i < 16; ++i) S[t][i] = 0.f;
    unsigned voff16 = lane * 16; asm volatile("" : "+v"(voff16));
    unsigned vrow_off = (lane >> 5) * (LDP1 * 2) + (lane & 31) * 16; asm volatile("" : "+v"(vrow_off));
#define RET_CP(goff, loff, npc) do { _Pragma("unroll") for (int i_ = 0; i_ < (npc); ++i_) { const int pc_ = wid + 8 * i_; \
        __builtin_amdgcn_global_load_lds((const unsigned*)((g_ + (goff) + pc_ * 1024) + voff16), (LAS unsigned*)(lds + (loff) + pc_ * 1024), 16, 0, 0); } } while (0)
#define RET_DMA_V(n) do { const unsigned char* gv_ = (const unsigned char*)(p.ws + WS_P1) + ((size_t)(b * 2048 + (n) * 64) * LDP1 + 2048 + h * 512 + half * 256) * 2; \
        _Pragma("unroll") for (int i_ = 0; i_ < 4; ++i_) { const int pc_ = wid + 8 * i_; \
        __builtin_amdgcn_global_load_lds((const unsigned*)((gv_ + (size_t)pc_ * (2 * LDP1 * 2)) + vrow_off), (LAS unsigned*)(lds + 73728 + ((n) & 1) * 32768 + pc_ * 1024), 16, 0, 0); } } while (0)
#define RET_DMA_A(n) do { const unsigned char* g_ = gblk + (size_t)(n) * ROP_STRIDE; RET_CP(0, 0, 4); RET_CP(65536, 32768, 1); RET_DMA_V(n); } while (0)
#define RET_DMA_B(n) do { const unsigned char* g_ = gblk + (size_t)(n) * ROP_STRIDE; RET_CP(32768, 40960, 4); } while (0)
    lds_barrier();
    RET_DMA_A(0);
    asm volatile("s_waitcnt vmcnt(0)" ::: "memory"); lds_barrier();
    for (int n = 0; n < 32; ++n) {
        RET_DMA_B(n);
        f32x16 O[2];
#pragma unroll
        for (int rt = 0; rt < 2; ++rt)
#pragma unroll
            for (int i = 0; i < 16; ++i) O[rt][i] = 0.f;
        const LAS unsigned short* vcol = (const LAS unsigned short*)(lds + 73728 + (n & 1) * 32768 + (wid * 32 + l31) * 2 + hh * (8 * 512));
#define RET_VFRAG(kc) ({ const LAS unsigned short* q_ = vcol + (kc) * (16 * 256); \
        u32x4 w_; w_.x = q_[0] | ((unsigned)q_[256] << 16); w_.y = q_[512] | ((unsigned)q_[768] << 16); w_.z = q_[1024] | ((unsigned)q_[1280] << 16); w_.w = q_[1536] | ((unsigned)q_[1792] << 16); \
        __builtin_bit_cast(bf16x8, w_); })
#pragma unroll
        for (int t = 0; t < 8; ++t)
#pragma unroll
            for (int s2 = 0; s2 < 2; ++s2) {
                const bf16x8 sb = packB(S[t], s2);
#pragma unroll
                for (int rt = 0; rt < 2; ++rt) O[rt] = MFMA32(LDSV((rt * 16 + 2 * t + s2) * 1024), sb, O[rt]);
                if (s2 == 1 && (t & 1)) __builtin_amdgcn_sched_barrier(0);
            }
#pragma unroll
        for (int kc = 0; kc < 4; ++kc) { const bf16x8 vb = RET_VFRAG(kc);
#pragma unroll
            for (int rt = (kc >> 1); rt < 2; ++rt) O[rt] = MFMA32(LDSV(32768 + (rt * 4 + kc) * 1024), vb, O[rt]); }
        const size_t tok0 = (size_t)b * 2048 + n * 64;
#pragma unroll
        for (int rt = 0; rt < 2; ++rt)
#pragma unroll
            for (int i = 0; i < 16; ++i) oraw[(tok0 + 32 * rt + crow(i, hh)) * 2048 + h * 512 + 32 * s + l31] = f2bf(O[rt][i]);
        asm volatile("s_waitcnt vmcnt(0)" ::: "memory"); lds_barrier();
        if (n + 1 < 32) RET_DMA_A(n + 1);
        bf16x8 Vb[4];
#pragma unroll
        for (int kc = 0; kc < 4; ++kc) Vb[kc] = RET_VFRAG(kc);
#pragma unroll
        for (int t = 0; t < 8; ++t) {
#pragma unroll
            for (int i = 0; i < 16; ++i) S[t][i] *= sdec;
#pragma unroll
            for (int kc = 0; kc < 4; ++kc) S[t] = MFMA32(LDSV(40960 + (t * 4 + kc) * 1024), Vb[kc], S[t]);
            if (t & 1) __builtin_amdgcn_sched_barrier(0);
        }
        asm volatile("s_waitcnt vmcnt(0)" ::: "memory"); lds_barrier();
    }
#undef RET_VFRAG
#undef RET_DMA_V
#undef RET_CP
#undef RET_DMA_A
#undef RET_DMA_B
    float* so = p.out + O_RP + (size_t)bh * 131072;
#pragma unroll
    for (int t = 0; t < 8; ++t)
#pragma unroll
        for (int i = 0; i < 16; ++i) so[(32 * t + crow(i, hh)) * 512 + 32 * s + l31] = S[t][i];
}
DI void ret_sample_item(const Params& p, int item, unsigned char* smem) {
    float* qT = (float*)smem;
    float* kT = qT + 2048;
    float* qraw = kT + 2048;
    float* kraw = qraw + 2048;
    float* qkm = kraw + 2048;
    const bf16_t* P1 = (const bf16_t*)(p.ws + WS_P1);
    int tid_ = threadIdx.x; asm volatile("" : "+v"(tid_));
    const int tid = tid_, lane = tid & 63, wid = tid >> 6;
    const int h = item & 3, b = item >> 2, tok0 = T_PR + b * 8;
    const float lg = ret_lg(h);
#pragma unroll
    for (int m = 0; m < 2; ++m) {
        const int e = tid + 512 * m, row = e >> 7, i = e & 127;
        const f32x2 tsv = ((const f32x2*)(p.ws + WS_TABS))[row * 128 + i]; const float cs = tsv.x, sn = tsv.y;
        const bf16_t* src = P1 + (size_t)(tok0 + row) * LDP1 + h * 256 + i;
        const float x1 = bf2f(src[0]), x2 = bf2f(src[128]), y1 = bf2f(src[1024]), y2 = bf2f(src[1152]);
        const float qa = x1 * cs - x2 * sn, qb = x1 * sn + x2 * cs, ka = (y1 * cs - y2 * sn) * 0.0625f, kb = (y1 * sn + y2 * cs) * 0.0625f;
        const float qdec = expf(lg * (float)(row + 1)), kdec = expf(lg * (float)(7 - row));
        qraw[row * 256 + i] = qa; qraw[row * 256 + 128 + i] = qb; kraw[row * 256 + i] = ka; kraw[row * 256 + 128 + i] = kb;
        qT[i * 8 + row] = qa * qdec; qT[(128 + i) * 8 + row] = qb * qdec; kT[i * 8 + row] = ka * kdec; kT[(128 + i) * 8 + row] = kb * kdec;
    }
    lds_barrier();
    { const int i = wid;
      for (int j = 0; j <= i; ++j) { float a = 0.f;
#pragma unroll
          for (int q = 0; q < 4; ++q) a += qraw[i * 256 + lane + 64 * q] * kraw[j * 256 + lane + 64 * q];
          a = wave_sum(a);
          if (lane == 0) qkm[i * 8 + j] = a * expf(lg * (float)(i - j)); } }
    lds_barrier();
    float* red = (float*)(smem + 40960);
    float* vsh = (float*)(smem + 106496);
    const int dv4 = tid & 127, dkq = tid >> 7;
    f32x4 v[8], ao[8];
#pragma unroll
    for (int c = 0; c < 8; ++c) { const u32x2 vv = *(const u32x2*)(P1 + (size_t)(tok0 + c) * LDP1 + 2048 + h * 512 + 4 * dv4);
        v[c] = (f32x4){bflo(vv.x), bfhi(vv.x), bflo(vv.y), bfhi(vv.y)}; ao[c] = (f32x4){0.f, 0.f, 0.f, 0.f};
        if (dkq == 0) *(f32x4*)(vsh + c * 512 + 4 * dv4) = v[c]; }
    const float sdec = expf(lg * 8.f);
    const float* S0 = p.st_ret + (size_t)item * 131072 + 4 * dv4; float* So = p.out + O_RS + (size_t)item * 131072 + 4 * dv4;
#pragma unroll 1
    for (int dk0 = 64 * dkq; dk0 < 64 * dkq + 64; dk0 += 16) {
        f32x4 sv[16];
#pragma unroll
        for (int r = 0; r < 16; ++r) sv[r] = __builtin_nontemporal_load((const f32x4*)(S0 + (size_t)(dk0 + r) * 512));
#pragma unroll
        for (int r = 0; r < 16; ++r) { const int dk = dk0 + r;
            const f32x4 q0 = *(const f32x4*)(qT + dk * 8), q1 = *(const f32x4*)(qT + dk * 8 + 4), k0 = *(const f32x4*)(kT + dk * 8), k1 = *(const f32x4*)(kT + dk * 8 + 4);
            const f32x4 s = sv[r];
            ao[0] += q0.x * s; ao[1] += q0.y * s; ao[2] += q0.z * s; ao[3] += q0.w * s; ao[4] += q1.x * s; ao[5] += q1.y * s; ao[6] += q1.z * s; ao[7] += q1.w * s;
            const f32x4 sn = sdec * s + k0.x * v[0] + k0.y * v[1] + k0.z * v[2] + k0.w * v[3] + k1.x * v[4] + k1.y * v[5] + k1.z * v[6] + k1.w * v[7];
            __builtin_nontemporal_store(sn, (f32x4*)(So + (size_t)dk * 512)); }
    }
#pragma unroll
    for (int c = 0; c < 8; ++c) *(f32x4*)(red + (dkq * 8 + c) * 512 + 4 * dv4) = ao[c];
    lds_barrier();
    bf16_t* oraw = (bf16_t*)(p.ws + WS_ORAW);
    { const int dv = tid; float vc[8];
#pragma unroll
      for (int c = 0; c < 8; ++c) vc[c] = vsh[c * 512 + dv];
#pragma unroll
      for (int c = 0; c < 8; ++c) { float o = red[c * 512 + dv] + red[(8 + c) * 512 + dv] + red[(16 + c) * 512 + dv] + red[(24 + c) * 512 + dv];
#pragma unroll
          for (int j = 0; j <= c; ++j) o += qkm[c * 8 + j] * vc[j];
          oraw[(size_t)(tok0 + c) * 2048 + h * 512 + dv] = f2bf(o); } }
    lds_barrier();
}
DI void phase_ret_scan(const Params& p, unsigned char* smem) {
    const int nscan = 64;
    if ((int)blockIdx.x < nscan) {
        _Pragma("unroll") for (int rp = 0; rp <= ((PROBE_MASK >> 15) & 1); ++rp)
        for (int item = blockIdx.x; item < 64; item += nscan) ret_scan_prompt(p, item, smem);
    } else {
        _Pragma("unroll") for (int rp = 0; rp <= ((PROBE_MASK >> 16) & 1); ++rp)
        for (int item = blockIdx.x - nscan; item < 512; item += gridDim.x - nscan) ret_sample_item(p, item, smem);
    }
}

DI void phase_ret_gate(const Params& p) {
    const int lane = threadIdx.x & 63, gw = blockIdx.x * 8 + (threadIdx.x >> 6), nw = gridDim.x * 8;
    const bf16_t* oraw = (const bf16_t*)(p.ws + WS_ORAW); const bf16_t* P1 = (const bf16_t*)(p.ws + WS_P1); bf16_t* og = (bf16_t*)(p.ws + WS_OG);
    for (int tok = gw; tok < T_TOK; tok += nw) {
        float o[32]; float ss = 0.f;
#pragma unroll
        for (int q = 0; q < 4; ++q) { const u32x4 a = *(const u32x4*)(oraw + (size_t)tok * 2048 + 32 * lane + 8 * q); const unsigned au[4] = {a.x, a.y, a.z, a.w};
#pragma unroll
            for (int i = 0; i < 4; ++i) { o[8 * q + 2 * i] = bflo(au[i]); o[8 * q + 2 * i + 1] = bfhi(au[i]); ss += o[8 * q + 2 * i] * o[8 * q + 2 * i] + o[8 * q + 2 * i + 1] * o[8 * q + 2 * i + 1]; } }
        ss = row16_sum(ss);
        const float rstd = rsqrtf(ss * (1.f / 512.f) + 1e-6f);
        const float* wn = p.onorm_b + 32 * lane;
#pragma unroll
        for (int q = 0; q < 4; ++q) { const u32x4 g = *(const u32x4*)(P1 + (size_t)tok * LDP1 + 4096 + 32 * lane + 8 * q); const unsigned gu[4] = {g.x, g.y, g.z, g.w}; unsigned r[4];
#pragma unroll
            for (int i = 0; i < 4; ++i) { const float v0 = o[8 * q + 2 * i] * rstd * wn[8 * q + 2 * i] * silu_f(bflo(gu[i])), v1 = o[8 * q + 2 * i + 1] * rstd * wn[8 * q + 2 * i + 1] * silu_f(bfhi(gu[i])); r[i] = pk_bf16(v0, v1); }
            *(u32x4*)(og + (size_t)tok * 2048 + 32 * lane + 8 * q) = (u32x4){r[0], r[1], r[2], r[3]}; }
    }
}

DI void phase_norm1(const Params& p) {
    const int lane = threadIdx.x & 63, gw = blockIdx.x * 8 + (threadIdx.x >> 6), nw = gridDim.x * 8;
    float* x1 = (float*)(p.ws + WS_X1); const float* part = (const float*)(p.ws + WS_PART1); bf16_t* out = (bf16_t*)(p.ws + WS_XN); const float* w = p.norm_w + 1024;
    for (int tok = gw; tok < T_TOK; tok += nw) {
        f32x4 v[4]; float ss = 0.f;
#pragma unroll
        for (int i = 0; i < 4; ++i) { const int c = 4 * lane + 256 * i;
            if (tok < T_PR) v[i] = *(const f32x4*)(x1 + (size_t)tok * 1024 + c);
            else { const size_t o = (size_t)(tok - T_PR) * 1024 + c; v[i] = *(const f32x4*)(p.xs + o);
#pragma unroll
                for (int s = 0; s < 4; ++s) v[i] += *(const f32x4*)(part + (size_t)s * 1048576 + o);
                *(f32x4*)(x1 + (size_t)tok * 1024 + c) = v[i]; }
            ss += v[i].x * v[i].x + v[i].y * v[i].y + v[i].z * v[i].z + v[i].w * v[i].w; }
        ss = wave_sum(ss);
        const float rstd = rsqrtf(ss * (1.f / 1024.f) + 1e-6f);
#pragma unroll
        for (int i = 0; i < 4; ++i) { const f32x4 ww = *(const f32x4*)(w + 4 * lane + 256 * i);
            u32x2 o; o.x = pk_bf16(v[i].x * rstd * ww.x, v[i].y * rstd * ww.y); o.y = pk_bf16(v[i].z * rstd * ww.z, v[i].w * rstd * ww.w);
            *(u32x2*)(out + (size_t)tok * 1024 + 4 * lane + 256 * i) = o; }
    }
}

DI void phase_final(const Params& p) {
    const int lane = threadIdx.x & 63, gw = blockIdx.x * 8 + (threadIdx.x >> 6), nw = gridDim.x * 8;
    const float* x2 = (const float*)(p.ws + WS_X2);
    for (int tok = gw; tok < T_TOK; tok += nw) {
        f32x4 v[4]; float ss = 0.f;
#pragma unroll
        for (int i = 0; i < 4; ++i) { const int c = 4 * lane + 256 * i;
            if (tok < T_PR) v[i] = *(const f32x4*)(x2 + (size_t)tok * 1024 + c);
            else { const size_t o = (size_t)(tok - T_PR) * 1024 + c; v[i] = *(const f32x4*)((const float*)(p.ws + WS_X1) + (size_t)tok * 1024 + c);
#pragma unroll
                for (int s = 0; s < 8; ++s) v[i] += *(const f32x4*)((const float*)(p.ws + WS_PART2) + (size_t)s * 1048576 + o); }
            ss += v[i].x * v[i].x + v[i].y * v[i].y + v[i].z * v[i].z + v[i].w * v[i].w; }
        ss = wave_sum(ss);
        const float rstd = rsqrtf(ss * (1.f / 1024.f) + 1e-6f);
#pragma unroll
        for (int i = 0; i < 4; ++i) { const f32x4 ww = *(const f32x4*)(p.fnorm_w + 4 * lane + 256 * i);
            *(f32x4*)(p.out + O_Y + (size_t)tok * 1024 + 4 * lane + 256 * i) = (f32x4){v[i].x * rstd * ww.x, v[i].y * rstd * ww.y, v[i].z * rstd * ww.z, v[i].w * rstd * ww.w}; }
    }
}

__global__ void __launch_bounds__(512) hybrid_fwd(Params p) {
    extern __shared__ __attribute__((aligned(16))) unsigned char smem[];
    cg::grid_group grid = cg::this_grid();
    volatile LAS unsigned* xst = (volatile LAS unsigned*)((LAS unsigned char*)smem + SMEM_XB);
    if (threadIdx.x < 4) xst[threadIdx.x] = 0u;
    __syncthreads();
    const XcdBarrier xb = xcd_barrier_post((unsigned*)(p.ws + WS_BAR), xst);
#ifdef ONLY_PH
#define RUN(k) ((k) == ONLY_PH)
#define SYNC(k)
#else
#define RUN(k) (p.ph_lo <= (k) && (k) < p.ph_hi)
#define SYNC(k) if (p.ph_lo < (k) && (k) < p.ph_hi) { if (p.use_cg) grid.sync(); else { xcd_barrier(xb); if ((PROBE_MASK >> 17) & 1) xcd_barrier(xb); } }
#endif
    _Pragma("unroll") for (int rep = 0; rep <= ((PROBE_MASK >> 0) & 1); ++rep) if (RUN(0)) phase_prep(p, smem);
    SYNC(1);
    _Pragma("unroll") for (int rep = 0; rep <= ((PROBE_MASK >> 1) & 1); ++rep) if (RUN(1)) { pg8::Gemm g{(const bf16_t*)(p.ws + WS_XN), (const bf16_t*)(p.ws + WS_WTA), T_TOK, LDP0, 1024, 1024}; pg8::StaticOrder S; S.init(g.M, g.N, gridDim.x, blockIdx.x);
                  pg8::EpiBf16 E{(bf16_t*)(p.ws + WS_P0), LDP0}; pg8::gemm_phase((LAS unsigned char*)smem, g, S, E); }
    SYNC(2);
    _Pragma("unroll") for (int rep = 0; rep <= ((PROBE_MASK >> 2) & 1); ++rep) if (RUN(2)) phase_gdn_prep(p, smem);
    SYNC(3);
    _Pragma("unroll") for (int rep = 0; rep <= ((PROBE_MASK >> 3) & 1); ++rep) if (RUN(3)) phase_gdn_scan(p, smem);
    SYNC(4);
    _Pragma("unroll") for (int rep = 0; rep <= ((PROBE_MASK >> 4) & 1); ++rep) if (RUN(4)) phase_gdn_gate(p);
    SYNC(5);
    _Pragma("unroll") for (int rep = 0; rep <= ((PROBE_MASK >> 5) & 1); ++rep) if (RUN(5)) { pg8::Gemm g{(const bf16_t*)(p.ws + WS_OG), (const bf16_t*)(p.ws + WS_WTOA), T_TOK, 1024, 1024, 1024}; pg8::MainOrder S{(int)gridDim.x, (int)blockIdx.x};
                  pg8::EpiRes E{(float*)(p.ws + WS_X1), p.xp, p.xs, T_PR}; pg8::gemm_phase((LAS unsigned char*)smem, g, S, E);
                  pg8::Gemm gt{g.A, g.Bt, T_TOK, 1024, 256, 1024}; pg8::TailOrder St{(int)gridDim.x, (int)blockIdx.x, 4, 256};
                  pg8::EpiPart Et{(float*)(p.ws + WS_PART1)}; pg8::gemm_phase((LAS unsigned char*)smem, gt, St, Et); }
    SYNC(6);
    _Pragma("unroll") for (int rep = 0; rep <= ((PROBE_MASK >> 6) & 1); ++rep) if (RUN(6)) phase_norm1(p);
    SYNC(7);
    _Pragma("unroll") for (int rep = 0; rep <= ((PROBE_MASK >> 7) & 1); ++rep) if (RUN(7)) { pg8::Gemm g{(const bf16_t*)(p.ws + WS_XN), (const bf16_t*)(p.ws + WS_WTB), T_TOK, LDP1, 1024, 1024}; pg8::StaticOrder S; S.init(g.M, g.N, gridDim.x, blockIdx.x);
                  pg8::EpiBf16 E{(bf16_t*)(p.ws + WS_P1), LDP1}; pg8::gemm_phase((LAS unsigned char*)smem, g, S, E); }
    SYNC(8);
    _Pragma("unroll") for (int rep = 0; rep <= ((PROBE_MASK >> 8) & 1); ++rep) if (RUN(8)) phase_ret_prep(p, smem);
    SYNC(9);
    _Pragma("unroll") for (int rep = 0; rep <= ((PROBE_MASK >> 9) & 1); ++rep) if (RUN(9)) phase_ret_scan(p, smem);
    SYNC(10);
    _Pragma("unroll") for (int rep = 0; rep <= ((PROBE_MASK >> 10) & 1); ++rep) if (RUN(10)) phase_ret_gate(p);
    SYNC(11);
    _Pragma("unroll") for (int rep = 0; rep <= ((PROBE_MASK >> 11) & 1); ++rep) if (RUN(11)) { pg8::Gemm g{(const bf16_t*)(p.ws + WS_OG), (const bf16_t*)(p.ws + WS_WTOB), T_TOK, 1024, 2048, 2048}; pg8::MainOrder S{(int)gridDim.x, (int)blockIdx.x};
                   pg8::EpiRes E{(float*)(p.ws + WS_X2), (const float*)(p.ws + WS_X1), (const float*)(p.ws + WS_X1), T_TOK}; pg8::gemm_phase((LAS unsigned char*)smem, g, S, E);
                   pg8::Gemm gt{g.A, g.Bt, T_TOK, 1024, 256, 2048}; pg8::TailOrder St{(int)gridDim.x, (int)blockIdx.x, 8, 256};
                   pg8::EpiPart Et{(float*)(p.ws + WS_PART2)}; pg8::gemm_phase((LAS unsigned char*)smem, gt, St, Et); }
    SYNC(12);
    _Pragma("unroll") for (int rep = 0; rep <= ((PROBE_MASK >> 12) & 1); ++rep) if (RUN(12)) phase_final(p);
}

#ifndef N_LAUNCH_SPLIT
#define N_LAUNCH_SPLIT 0
#endif

extern "C" void kernel_launch(void* const* d_in, const int* in_sizes, int n_in, void* d_out, int out_size, void* d_ws, size_t ws_size, hipStream_t stream) {
    static int grid_blocks = 0;
    if (!grid_blocks) {
        hipFuncSetAttribute((const void*)hybrid_fwd, hipFuncAttributeMaxDynamicSharedMemorySize, (int)SMEM_BYTES);
        int dev = 0, cus = 0, per_cu = 0;
        hipGetDevice(&dev);
        hipDeviceGetAttribute(&cus, hipDeviceAttributeMultiprocessorCount, dev);
        hipOccupancyMaxActiveBlocksPerMultiprocessor(&per_cu, hybrid_fwd, 512, SMEM_BYTES);
        if (per_cu < 1) per_cu = 1;
        grid_blocks = cus * 1;
        if (grid_blocks < 72) { fprintf(stderr, "too few CUs: %d\n", grid_blocks); }
    }
    if (ws_size < WS_TOTAL) { fprintf(stderr, "workspace too small: %zu < %zu\n", ws_size, (size_t)WS_TOTAL); return; }
    hipMemsetAsync((unsigned char*)d_ws + WS_BAR, 0, 16384, stream);
    Params p{};
    p.xp = (const float*)d_in[0]; p.xs = (const float*)d_in[1]; p.st_gdn = (const float*)d_in[2]; p.st_conv = (const float*)d_in[3]; p.st_ret = (const float*)d_in[4];
    p.norm_w = (const float*)d_in[5]; p.w_in_a = (const float*)d_in[6]; p.conv_w = (const float*)d_in[7]; p.a_log = (const float*)d_in[8]; p.dt_bias = (const float*)d_in[9];
    p.onorm_a = (const float*)d_in[10]; p.w_out_a = (const float*)d_in[11]; p.w_in_b = (const float*)d_in[12]; p.onorm_b = (const float*)d_in[13]; p.w_out_b = (const float*)d_in[14];
    p.fnorm_w = (const float*)d_in[15];
    p.out = (float*)d_out; p.ws = (unsigned char*)d_ws;
#if N_LAUNCH_SPLIT
    for (int ph = 0; ph < NPH; ++ph) {
        p.ph_lo = ph; p.ph_hi = ph + 1;
        void* args[] = {&p};
        hipError_t e = hipLaunchCooperativeKernel((const void*)hybrid_fwd, dim3(grid_blocks), dim3(512), args, SMEM_BYTES, stream);
        if (e != hipSuccess) fprintf(stderr, "launch failed (phase %d): %s\n", ph, hipGetErrorString(e));
    }
#else
    p.ph_lo = 0; p.ph_hi = NPH;
    void* args[] = {&p};
    hipError_t e = hipLaunchCooperativeKernel((const void*)hybrid_fwd, dim3(grid_blocks), dim3(512), args, SMEM_BYTES, stream);
    if (e != hipSuccess) fprintf(stderr, "cooperative launch failed: %s (grid %d)\n", hipGetErrorString(e), grid_blocks);
#endif
}
```

```cpp
#include <hip/hip_runtime.h>
#include <hip/hip_cooperative_groups.h>
#include <cstdio>
namespace cg = cooperative_groups;

#define DI __device__ __forceinline__
#define LAS __attribute__((address_space(3)))
typedef unsigned short bf16_t;
typedef short bf16x8 __attribute__((ext_vector_type(8)));
typedef float f32x2 __attribute__((ext_vector_type(2)));
typedef float f32x4 __attribute__((ext_vector_type(4)));
typedef float f32x16 __attribute__((ext_vector_type(16)));
typedef unsigned u32x2 __attribute__((ext_vector_type(2)));
typedef unsigned u32x4 __attribute__((ext_vector_type(4)));
typedef __bf16 bf2_t __attribute__((ext_vector_type(2)));

constexpr int T_TOK = 17408, T_PR = 16384, DM = 1024;
constexpr int LDP0 = 4352, LDP1 = 6144;
constexpr int NPH = 13;
#ifndef PROBE_MASK
#define PROBE_MASK 0
#endif
constexpr size_t SMEM_BYTES = 153600;

constexpr size_t WS_WTA = 0;
constexpr size_t WS_WTOA = WS_WTA + (size_t)4352 * 1024 * 2;
constexpr size_t WS_WTB = WS_WTOA + (size_t)1024 * 1024 * 2;
constexpr size_t WS_WTOB = WS_WTB + (size_t)6144 * 1024 * 2;
constexpr size_t WS_XN = WS_WTOB + (size_t)1024 * 2048 * 2;
constexpr size_t WS_ORAW = WS_XN + (size_t)T_TOK * 1024 * 2;
constexpr size_t WS_OG = WS_ORAW + (size_t)T_TOK * 2048 * 2;
constexpr size_t WS_X1 = WS_OG + (size_t)T_TOK * 2048 * 2;
constexpr size_t WS_X2 = WS_X1 + (size_t)T_TOK * 1024 * 4;
constexpr size_t ROP_STRIDE = 139264;
constexpr size_t WS_ROP = WS_X2 + (size_t)T_TOK * 1024 * 4;
constexpr size_t WS_RA = WS_ROP + ROP_STRIDE * 1024;
constexpr size_t WS_P0 = WS_RA;
constexpr size_t GOP_STRIDE = 73984;
constexpr size_t WS_GOP = WS_P0 + (size_t)T_TOK * LDP0 * 2;
constexpr size_t WS_PART1 = WS_GOP;
constexpr size_t WS_PART2 = WS_ROP;
constexpr size_t WS_P1 = WS_RA;
constexpr size_t WS_END = WS_GOP + GOP_STRIDE * 2048;
static_assert((size_t)T_TOK * LDP1 * 2 <= WS_END - WS_RA, "P1 alias");
constexpr size_t WS_TABR = WS_END;
constexpr size_t WS_TABC = WS_TABR + 65536;
constexpr size_t WS_TABS = WS_TABC + 32768;
constexpr size_t WS_BAR = WS_TABS + 8192;
constexpr size_t WS_TOTAL = WS_BAR + 16384;
constexpr size_t SMEM_XB = 147456;

constexpr size_t O_Y = 0, O_GSP = 17825792, O_GCP = 18874368, O_RP = 18948096, O_GSS = 23142400, O_GCS = 39919616, O_RS = 41099264;

struct Params {
    const float *xp, *xs, *st_gdn, *st_conv, *st_ret, *norm_w, *w_in_a, *conv_w, *a_log, *dt_bias, *onorm_a, *w_out_a, *w_in_b, *onorm_b, *w_out_b, *fnorm_w;
    float* out;
    unsigned char* ws;
    int ph_lo, ph_hi;
    int use_cg, pad0;
};

DI unsigned pk_bf16(float a, float b) { f32x2 v = {a, b}; bf2_t r = __builtin_convertvector(v, bf2_t); return __builtin_bit_cast(unsigned, r); }
DI bf16_t f2bf(float a) { return (bf16_t)(pk_bf16(a, 0.f) & 0xffffu); }
DI float bf2f(bf16_t b) { return __uint_as_float(((unsigned)b) << 16); }
DI float bflo(unsigned u) { return __uint_as_float(u << 16); }
DI float bfhi(unsigned u) { return __uint_as_float(u & 0xffff0000u); }
DI float silu_f(float x) { return x * __builtin_amdgcn_rcpf(1.f + __expf(-x)); }
DI float row16_sum(float v) {
    v += __builtin_bit_cast(float, __builtin_amdgcn_update_dpp(0, __builtin_bit_cast(int, v), 0xB1, 0xF, 0xF, true));
    v += __builtin_bit_cast(float, __builtin_amdgcn_update_dpp(0, __builtin_bit_cast(int, v), 0x4E, 0xF, 0xF, true));
    v += __builtin_bit_cast(float, __builtin_amdgcn_update_dpp(0, __builtin_bit_cast(int, v), 0x124, 0xF, 0xF, true));
    v += __builtin_bit_cast(float, __builtin_amdgcn_update_dpp(0, __builtin_bit_cast(int, v), 0x128, 0xF, 0xF, true));
    return v;
}
DI float wave_sum(float v) {
    v = row16_sum(v);
    v += __shfl_xor(v, 16);
    v += __shfl_xor(v, 32);
    return v;
}
DI bf16x8 packB(const f32x16& x, const int s) {
    u32x4 p; p.x = pk_bf16(x[8 * s], x[8 * s + 1]); p.y = pk_bf16(x[8 * s + 2], x[8 * s + 3]); p.z = pk_bf16(x[8 * s + 4], x[8 * s + 5]); p.w = pk_bf16(x[8 * s + 6], x[8 * s + 7]);
    return __builtin_bit_cast(bf16x8, p);
}
DI bf16x8 ldA_perm(const bf16_t* rowp, int hh) {
    const u32x2 lo = *(const u32x2*)(rowp + 4 * hh), hi = *(const u32x2*)(rowp + 8 + 4 * hh);
    u32x4 v = {lo.x, lo.y, hi.x, hi.y}; return __builtin_bit_cast(bf16x8, v);
}
DI bf16x8 ld16(const bf16_t* p) { return __builtin_bit_cast(bf16x8, *(const u32x4*)p); }
#define MFMA32(a, b, c) __builtin_amdgcn_mfma_f32_32x32x16_bf16((a), (b), (c), 0, 0, 0)
DI void split2(float a, float b, unsigned& hi, unsigned& lo) { hi = pk_bf16(a, b); lo = pk_bf16(a - bflo(hi), b - bfhi(hi)); }
DI void split8(const f32x4& v0, const f32x4& v1, bf16x8& hi, bf16x8& lo) {
    unsigned h0, h1, h2, h3, l0, l1, l2, l3; split2(v0.x, v0.y, h0, l0); split2(v0.z, v0.w, h1, l1); split2(v1.x, v1.y, h2, l2); split2(v1.z, v1.w, h3, l3);
    const u32x4 h = {h0, h1, h2, h3}, l = {l0, l1, l2, l3};
    hi = __builtin_bit_cast(bf16x8, h); lo = __builtin_bit_cast(bf16x8, l);
}
DI void split4z(float a, float b, float c, float d, bf16x8& hi, bf16x8& lo) {
    unsigned h0, h1, l0, l1; split2(a, b, h0, l0); split2(c, d, h1, l1);
    const u32x4 h = {h0, h1, 0u, 0u}, l = {l0, l1, 0u, 0u};
    hi = __builtin_bit_cast(bf16x8, h); lo = __builtin_bit_cast(bf16x8, l);
}
DI int crow(int i, int hh) { return (i & 3) + 8 * (i >> 2) + 4 * hh; }
DI void lds_barrier() { asm volatile("s_waitcnt lgkmcnt(0)" ::: "memory"); __builtin_amdgcn_s_barrier(); asm volatile("" ::: "memory"); }
DI int opaque_tid() { int t = threadIdx.x; asm volatile("" : "+v"(t)); return t; }


#define XB_TMO      128
#define XB_XCNT(j)  (256  + 64 * (j))
#define XB_XSUB(j)  (1280 + 64 * (j))
#define XB_XGEN(j)  (2304 + 64 * (j))
#define XB_TOP      3328
#define XB_TOPGEN   3392
#define XCD_BAR_WORDS 3456
#define XB_SPIN_CAP (1u << 18)
DI unsigned xb_ld(unsigned* p) { return __hip_atomic_load(p, __ATOMIC_RELAXED, __HIP_MEMORY_SCOPE_AGENT); }
DI unsigned xb_add(unsigned* p, unsigned v) { return __hip_atomic_fetch_add(p, v, __ATOMIC_RELAXED, __HIP_MEMORY_SCOPE_AGENT); }
DI unsigned xb_xcc_id() { return (unsigned)__builtin_amdgcn_s_getreg((3 << 11) | 20) & 0xFu; }
#define XB_SPIN(cond, bar) do { unsigned _sp = 0; while (cond) { __builtin_amdgcn_s_sleep(1); \
    if ((++_sp & 255u) == 0u) { if (xb_ld(&(bar)[XB_TMO])) break; if (_sp > XB_SPIN_CAP) { atomicAdd(&(bar)[XB_TMO], 1u); break; } } } } while (0)
struct XcdBarrier { unsigned* bar; unsigned x; volatile LAS unsigned* st; };
DI XcdBarrier xcd_barrier_post(unsigned* bar, volatile LAS unsigned* st) {
    XcdBarrier b; b.bar = bar; b.x = xb_xcc_id(); b.st = st;
    if (threadIdx.x == 0) (void)xb_add(&bar[XB_XCNT(b.x)], 1u);
    return b;
}
DI void xcd_barrier_complete(unsigned* bar, unsigned x, unsigned& nloc, unsigned& nx) {
    const unsigned G = gridDim.x * gridDim.y * gridDim.z;
    unsigned sum, cnt, mine, sp = 0u;
    for (;;) {
        sum = 0u; cnt = 0u; mine = 0u;
#pragma unroll
        for (unsigned j = 0; j < 16; ++j) { const unsigned c = xb_ld(&bar[XB_XCNT(j)]); sum += c; cnt += (c > 0u) ? 1u : 0u; mine = (j == x) ? c : mine; }
        if (sum == G) break;
        __builtin_amdgcn_s_sleep(1);
        if ((++sp & 255u) == 0u) { if (xb_ld(&bar[XB_TMO])) break; if (sp > XB_SPIN_CAP) { atomicAdd(&bar[XB_TMO], 1u); break; } }
    }
    nloc = mine > 0u ? mine : 1u; nx = cnt > 0u ? cnt : 1u;
}
DI void xcd_barrier_slow(unsigned* bar, unsigned x, volatile LAS unsigned* st) {
    __builtin_amdgcn_s_waitcnt(0);
    unsigned nloc = st[0], nx = st[1];
    if (nloc == 0u) { xcd_barrier_complete(bar, x, nloc, nx); st[0] = nloc; st[1] = nx; }
    const unsigned old = xb_add(&bar[XB_XSUB(x)], 1u);
    const unsigned gen = old / nloc;
    if (old + 1u == (gen + 1u) * nloc) {
        __builtin_amdgcn_fence(__ATOMIC_RELEASE, "agent");
        asm volatile("s_waitcnt vmcnt(0)" ::: "memory");
        const unsigned og = xb_add(&bar[XB_TOP], 1u);
        const unsigned tg = og / nx;
        if (og + 1u == (tg + 1u) * nx) xb_add(&bar[XB_TOPGEN], 1u);
        else XB_SPIN(xb_ld(&bar[XB_TOPGEN]) == tg, bar);
        __builtin_amdgcn_fence(__ATOMIC_ACQUIRE, "agent");
        xb_add(&bar[XB_XGEN(x)], 1u);
        asm volatile("s_waitcnt vmcnt(0)" ::: "memory");
    } else {
        XB_SPIN(xb_ld(&bar[XB_XGEN(x)]) == gen, bar);
        __builtin_amdgcn_fence(__ATOMIC_ACQUIRE, "agent");
        asm volatile("s_waitcnt vmcnt(0)" ::: "memory");
    }
}
DI void xcd_barrier(const XcdBarrier& b) {
    asm volatile("s_waitcnt vmcnt(0)" ::: "memory");
    __syncthreads();
    if (threadIdx.x == 0) xcd_barrier_slow(b.bar, b.x, b.st);
    __syncthreads();
}

namespace pg8 {
constexpr int BM = 256, BK = 64, HALF = 128, HTB = HALF * BK * 2, STAGE_BYTES = 8 * HTB, NXCD = 8, WGM = 8;
DI int lds_byte(int r, int c) { const int st = (r >> 4) * 2 + (c >> 5), rr = r & 15, cc = c & 31, ob = rr * 64 + cc * 2; return st * 1024 + (ob ^ (((ob >> 9) & 1) << 5)); }
DI void stage_rc(int b, int& R, int& C) { const int st = b / 1024, sb = b % 1024, swz = sb ^ (((sb >> 9) & 1) << 5); R = (st >> 1) * 16 + swz / 64; C = (st & 1) * 32 + (swz % 64) / 2; }
DI int perm32(int rho) { const int n = rho >> 4, i = rho & 15; return 8 * (i >> 2) + 4 * n + (i & 3); }
struct Unit { int pm, pn, koff, slice; };
struct Gemm { const bf16_t* A; const bf16_t* Bt; int M, N, K, ld; };
struct StaticOrder {
    int nM, nN, nwg, G, c;
    DI void init(int M, int N, int G_, int c_) { nM = M / BM; nN = N / BM; nwg = nM * nN; G = G_; c = c_; }
    DI bool next(int i, Unit& u) const {
        const long L = (long)i * G + c; if (L >= nwg) return false;
        int wgid = (int)L; { const int q = nwg / NXCD, r = nwg % NXCD, xcd = wgid % NXCD, off = wgid / NXCD; wgid = (xcd < r ? xcd * (q + 1) : r * (q + 1) + (xcd - r) * q) + off; }
        const int nig = WGM * nN, gid = wgid / nig, fm = gid * WGM, gsz = (nM - fm) < WGM ? (nM - fm) : WGM;
        u.pm = fm + ((wgid % nig) % gsz); u.pn = (wgid % nig) / gsz; u.koff = 0; u.slice = 0; return true;
    }
};
struct MainOrder { int G, c; DI bool next(int i, Unit& u) const { const int L = i * G + c; if (L >= 256) return false; u.pm = L >> 2; u.pn = L & 3; u.koff = 0; u.slice = 0; return true; } };
struct TailOrder { int G, c, NS, klen; DI bool next(int i, Unit& u) const { const int L = i * G + c; if (L >= 16 * NS) return false; const int un = L / NS; u.slice = L - un * NS; u.pm = 64 + (un >> 2); u.pn = un & 3; u.koff = u.slice * klen; return true; } };
struct EpiBf16 {
    static constexpr bool PERM = true;
    bf16_t* O; int ldc;
    DI void operator()(const f32x4 (&acc)[2][2][4][2], const Unit& u, int wr, int wc, int fr, int fq) const {
        const int row0 = u.pm * BM + wr * 64 + fr, col0 = u.pn * BM + wc * 32 + 8 * fq;
#pragma unroll
        for (int ai = 0; ai < 2; ++ai)
#pragma unroll
            for (int m = 0; m < 4; ++m) { bf16_t* rowp = O + (size_t)(row0 + ai * HALF + m * 16) * ldc + col0;
#pragma unroll
                for (int bj = 0; bj < 2; ++bj) { const f32x4 v0 = acc[ai][bj][m][0], v1 = acc[ai][bj][m][1];
                    u32x4 w; w.x = pk_bf16(v0[0], v0[1]); w.y = pk_bf16(v0[2], v0[3]); w.z = pk_bf16(v1[0], v1[1]); w.w = pk_bf16(v1[2], v1[3]);
                    *(u32x4*)(rowp + bj * HALF) = w; } }
    }
};
struct EpiRes {
    static constexpr bool PERM = false;
    float* O; const float* resA; const float* resB; int split;
    DI void operator()(const f32x4 (&acc)[2][2][4][2], const Unit& u, int wr, int wc, int fr, int fq) const {
        const int row0 = u.pm * BM + wr * 64 + fr, col0 = u.pn * BM + wc * 32 + 4 * fq;
#pragma unroll
        for (int ai = 0; ai < 2; ++ai)
#pragma unroll
            for (int m = 0; m < 4; ++m) { const int r = row0 + ai * HALF + m * 16;
                const float* rp = (r < split ? resA + (size_t)r * 1024 : resB + (size_t)(r - split) * 1024) + col0; float* op = O + (size_t)r * 1024 + col0;
#pragma unroll
                for (int bj = 0; bj < 2; ++bj)
#pragma unroll
                    for (int n = 0; n < 2; ++n) *(f32x4*)(op + bj * HALF + n * 16) = acc[ai][bj][m][n] + *(const f32x4*)(rp + bj * HALF + n * 16); }
    }
};

template <bool RES_BF16> struct EpiResB {
    static constexpr bool PERM = false;
    bf16_t* O; const void* res;
    DI void operator()(const f32x4 (&acc)[2][2][4][2], const Unit& u, int wr, int wc, int fr, int fq) const {
        const int row0 = u.pm * BM + wr * 64 + fr, col0 = u.pn * BM + wc * 32 + 4 * fq;
#pragma unroll
        for (int ai = 0; ai < 2; ++ai)
#pragma unroll
            for (int m = 0; m < 4; ++m) { const size_t o = (size_t)(row0 + ai * HALF + m * 16) * 1024 + col0;
#pragma unroll
                for (int bj = 0; bj < 2; ++bj)
#pragma unroll
                    for (int n = 0; n < 2; ++n) { const size_t oo = o + bj * HALF + n * 16; f32x4 rv;
                        if (RES_BF16) { const u32x2 t = *(const u32x2*)((const bf16_t*)res + oo); rv = (f32x4){bflo(t.x), bfhi(t.x), bflo(t.y), bfhi(t.y)}; }
                        else rv = *(const f32x4*)((const float*)res + oo);
                        const f32x4 v = acc[ai][bj][m][n] + rv; u32x2 w; w.x = pk_bf16(v.x, v.y); w.y = pk_bf16(v.z, v.w);
                        *(u32x2*)(O + oo) = w; } }
    }
};

struct EpiPart {
    static constexpr bool PERM = false;
    float* P;
    DI void operator()(const f32x4 (&acc)[2][2][4][2], const Unit& u, int wr, int wc, int fr, int fq) const {
        const int row0 = (u.pm - 64) * BM + wr * 64 + fr, col0 = u.pn * BM + wc * 32 + 4 * fq;
        float* base = P + (size_t)u.slice * 1048576;
#pragma unroll
        for (int ai = 0; ai < 2; ++ai)
#pragma unroll
            for (int m = 0; m < 4; ++m) { float* op = base + (size_t)(row0 + ai * HALF + m * 16) * 1024 + col0;
#pragma unroll
                for (int bj = 0; bj < 2; ++bj)
#pragma unroll
                    for (int n = 0; n < 2; ++n) *(f32x4*)(op + bj * HALF + n * 16) = acc[ai][bj][m][n]; }
    }
};

template <class Epi, class Sched>
DI void gemm_phase(LAS unsigned char* lds, const Gemm g, const Sched& S, const Epi& E) {
    const int tid = opaque_tid(), wid = __builtin_amdgcn_readfirstlane(tid >> 6), lane = tid & 63, wr = wid >> 2, wc = wid & 3, fr = lane & 15, fq = lane >> 4;
    const int K = g.ld, nt = g.K / BK;
    unsigned voffA[2], voffB[2];
#pragma unroll
    for (int i = 0; i < 2; ++i) { int R, C; stage_rc(tid * 16 + i * 8192, R, C); const int Rb = Epi::PERM ? ((R & ~31) + perm32(R & 31)) : R;
        voffA[i] = (unsigned)(R * K + C) * 2u; voffB[i] = (unsigned)(Rb * K + C) * 2u; }
    const size_t kstep = (size_t)(BK * 2);
    const size_t hstep = (size_t)HALF * K * 2;
    const size_t tstep = 2 * hstep;
    const unsigned ldsw = (unsigned)wid * 1024u;
    const int aoff = lds_byte(wr * 64 + fr, fq * 8), boff = lds_byte(wc * 32 + fr, fq * 8);
#define PG8_SA(b, h) (((b) * 2 + (h)) * HTB)
#define PG8_SB(b, h) ((4 + (b) * 2 + (h)) * HTB)
#define PG8_STAGE(bufoff, gbase, voff) do { _Pragma("unroll") for (int _i = 0; _i < 2; ++_i) \
        __builtin_amdgcn_global_load_lds((const unsigned*)((const char*)(gbase) + (voff)[_i]), (LAS unsigned*)(lds + (bufoff) + ldsw + _i * 8192), 16, 0, 0); } while (0)
#define PG8_LDA(dst, b, h) do { _Pragma("unroll") for (int m = 0; m < 4; ++m) _Pragma("unroll") for (int k = 0; k < 2; ++k) dst[m][k] = *(const LAS bf16x8*)(lds + PG8_SA(b, h) + aoff + m * 2048 + k * 1024); } while (0)
#define PG8_LDB(dst, b, h) do { _Pragma("unroll") for (int n = 0; n < 2; ++n) _Pragma("unroll") for (int k = 0; k < 2; ++k) dst[n][k] = *(const LAS bf16x8*)(lds + PG8_SB(b, h) + boff + n * 2048 + k * 1024); } while (0)
#define PG8_MMA(ai, bj, At, Bt) do { __builtin_amdgcn_s_setprio(1); _Pragma("unroll") for (int m = 0; m < 4; ++m) _Pragma("unroll") for (int n = 0; n < 2; ++n) _Pragma("unroll") for (int k = 0; k < 2; ++k) \
        acc[ai][bj][m][n] = __builtin_amdgcn_mfma_f32_16x16x32_bf16(Bt[n][k], At[m][k], acc[ai][bj][m][n], 0, 0, 0); __builtin_amdgcn_s_setprio(0); } while (0)
#define PG8_WAIT_V(n) asm volatile("s_waitcnt vmcnt(" #n ")" ::: "memory")
#define PG8_WAIT_L(n) asm volatile("s_waitcnt lgkmcnt(" #n ")" ::: "memory")
#define PG8_BAR __builtin_amdgcn_s_barrier()
#define PG8_SCHED __builtin_amdgcn_sched_barrier(0)
    Unit cur, nxt; int ui = 0;
    if (!S.next(0, cur)) return;
    f32x4 acc[2][2][4][2];
#pragma unroll
    for (int a = 0; a < 2; ++a)
#pragma unroll
        for (int b = 0; b < 2; ++b)
#pragma unroll
            for (int m = 0; m < 4; ++m)
#pragma unroll
                for (int n = 0; n < 2; ++n) acc[a][b][m][n] = (f32x4){0.f, 0.f, 0.f, 0.f};
    bf16x8 At[4][2], B0[2][2], B1[2][2];
    const char* cA = (const char*)g.A + (size_t)cur.pm * tstep + (size_t)cur.koff * 2; const char* cB = (const char*)g.Bt + (size_t)cur.pn * tstep + (size_t)cur.koff * 2;
    PG8_STAGE(PG8_SB(0, 0), cB, voffB); PG8_STAGE(PG8_SA(0, 0), cA, voffA); PG8_STAGE(PG8_SB(0, 1), cB + hstep, voffB); PG8_STAGE(PG8_SA(0, 1), cA + hstep, voffA);
    if (wr == 1) PG8_BAR;
    PG8_WAIT_V(4); PG8_BAR;
    PG8_STAGE(PG8_SB(1, 0), cB + kstep, voffB); PG8_STAGE(PG8_SA(1, 0), cA + kstep, voffA); PG8_STAGE(PG8_SB(1, 1), cB + hstep + kstep, voffB);
    PG8_WAIT_V(6); PG8_BAR;
    for (;;) {
        const bool has_next = S.next(ui + 1, nxt);
        const char* nA = has_next ? (const char*)g.A + (size_t)nxt.pm * tstep + (size_t)nxt.koff * 2 : cA; const char* nB = has_next ? (const char*)g.Bt + (size_t)nxt.pn * tstep + (size_t)nxt.koff * 2 : cB;
        for (int t = 0; t < nt; t += 2) {
            const bool last = (t == nt - 2);
            const char* a1 = cA + (size_t)(t + 1) * kstep;
            const char* a2 = last ? nA : cA + (size_t)(t + 2) * kstep; const char* b2 = last ? nB : cB + (size_t)(t + 2) * kstep;
            const char* a3 = a2 + kstep; const char* b3 = b2 + kstep;
            PG8_LDB(B0, 0, 0); PG8_SCHED; PG8_LDA(At, 0, 0); PG8_STAGE(PG8_SA(1, 1), a1 + hstep, voffA);
            PG8_WAIT_L(8); PG8_BAR; PG8_WAIT_L(0); PG8_MMA(0, 0, At, B0); PG8_BAR; PG8_SCHED;
            PG8_LDB(B1, 0, 1); PG8_STAGE(PG8_SB(0, 0), b2, voffB);
            PG8_BAR; PG8_WAIT_L(0); PG8_MMA(0, 1, At, B1); PG8_BAR;
            PG8_LDA(At, 0, 1); PG8_STAGE(PG8_SA(0, 0), a2, voffA);
            PG8_BAR; PG8_WAIT_L(0); PG8_MMA(1, 0, At, B0); PG8_BAR; PG8_SCHED;
            PG8_STAGE(PG8_SB(0, 1), b2 + hstep, voffB);
            PG8_WAIT_V(6); PG8_BAR; PG8_MMA(1, 1, At, B1); PG8_BAR;
            PG8_LDB(B0, 1, 0); PG8_SCHED; PG8_LDA(At, 1, 0); PG8_STAGE(PG8_SA(0, 1), a2 + hstep, voffA);
            PG8_WAIT_L(8); PG8_BAR; PG8_WAIT_L(0); PG8_MMA(0, 0, At, B0); PG8_BAR; PG8_SCHED;
            PG8_LDB(B1, 1, 1); PG8_STAGE(PG8_SB(1, 0), b3, voffB);
            PG8_BAR; PG8_WAIT_L(0); PG8_MMA(0, 1, At, B1); PG8_BAR;
            PG8_LDA(At, 1, 1); PG8_STAGE(PG8_SA(1, 0), a3, voffA);
            PG8_BAR; PG8_WAIT_L(0); PG8_MMA(1, 0, At, B0); PG8_BAR; PG8_SCHED;
            PG8_STAGE(PG8_SB(1, 1), b3 + hstep, voffB);
            PG8_WAIT_V(6); PG8_BAR; PG8_MMA(1, 1, At, B1); PG8_BAR;
        }
        E(acc, cur, wr, wc, fr, fq);
        if (!has_next) break;
#pragma unroll
        for (int a = 0; a < 2; ++a)
#pragma unroll
            for (int b = 0; b < 2; ++b)
#pragma unroll
                for (int m = 0; m < 4; ++m)
#pragma unroll
                    for (int n = 0; n < 2; ++n) acc[a][b][m][n] = (f32x4){0.f, 0.f, 0.f, 0.f};
        cur = nxt; cA = nA; cB = nB; ++ui;
    }
    PG8_WAIT_V(0);
    if (wr == 0) PG8_BAR;
    PG8_BAR;
#undef PG8_SA
#undef PG8_SB
#undef PG8_STAGE
#undef PG8_LDA
#undef PG8_LDB
#undef PG8_MMA
#undef PG8_WAIT_V
#undef PG8_WAIT_L
#undef PG8_BAR
#undef PG8_SCHED
}
}

DI void transpose_tile(const float* W, int ldw, int nvalid, int k0, int n0, bf16_t* Wt, int ldt, float* tile  ) {
    const int tid = threadIdx.x;
#pragma unroll
    for (int m = 0; m < 8; ++m) { const int e = tid + 512 * m, kk = e >> 6, nn = e & 63;
        tile[kk * 65 + nn] = (n0 + nn < nvalid) ? W[(size_t)(k0 + kk) * ldw + n0 + nn] : 0.f; }
    lds_barrier();
    { const int nn = tid >> 3, kq = tid & 7; float v[8];
#pragma unroll
      for (int j = 0; j < 8; ++j) v[j] = tile[(kq * 8 + j) * 65 + nn];
      u32x4 w; w.x = pk_bf16(v[0], v[1]); w.y = pk_bf16(v[2], v[3]); w.z = pk_bf16(v[4], v[5]); w.w = pk_bf16(v[6], v[7]);
      *(u32x4*)(Wt + (size_t)(n0 + nn) * ldt + k0 + kq * 8) = w; }
    lds_barrier();
}
DI void rmsnorm_bf16(const float* srcA, const float* srcB, int split, const float* w, bf16_t* out) {
    const int lane = threadIdx.x & 63, gw = blockIdx.x * 8 + (threadIdx.x >> 6), nw = gridDim.x * 8;
    for (int tok = gw; tok < T_TOK; tok += nw) {
        const float* src = tok < split ? srcA + (size_t)tok * 1024 : srcB + (size_t)(tok - split) * 1024;
        f32x4 v[4]; float ss = 0.f;
#pragma unroll
        for (int i = 0; i < 4; ++i) { v[i] = *(const f32x4*)(src + 4 * lane + 256 * i); ss += v[i].x * v[i].x + v[i].y * v[i].y + v[i].z * v[i].z + v[i].w * v[i].w; }
        ss = wave_sum(ss);
        const float rstd = rsqrtf(ss * (1.f / 1024.f) + 1e-6f);
#pragma unroll
        for (int i = 0; i < 4; ++i) { const f32x4 ww = *(const f32x4*)(w + 4 * lane + 256 * i);
            u32x2 o; o.x = pk_bf16(v[i].x * rstd * ww.x, v[i].y * rstd * ww.y); o.y = pk_bf16(v[i].z * rstd * ww.z, v[i].w * rstd * ww.w);
            *(u32x2*)(out + (size_t)tok * 1024 + 4 * lane + 256 * i) = o; }
    }
}
DI void phase_prep(const Params& p, unsigned char* smem) {
    float* tile = (float*)smem;
    bf16_t* wta = (bf16_t*)(p.ws + WS_WTA); bf16_t* wtoa = (bf16_t*)(p.ws + WS_WTOA); bf16_t* wtb = (bf16_t*)(p.ws + WS_WTB); bf16_t* wtob = (bf16_t*)(p.ws + WS_WTOB);
    for (int t = blockIdx.x; t < 3392; t += gridDim.x) {
        if (t < 1088) transpose_tile(p.w_in_a, 4112, 4112, (t & 15) * 64, (t >> 4) * 64, wta, 1024, tile);
        else if (t < 1344) { const int u = t - 1088; transpose_tile(p.w_out_a, 1024, 1024, (u & 15) * 64, (u >> 4) * 64, wtoa, 1024, tile); }
        else if (t < 2880) { const int u = t - 1344; transpose_tile(p.w_in_b, 6144, 6144, (u & 15) * 64, (u >> 4) * 64, wtb, 1024, tile); }
        else { const int u = t - 2880; transpose_tile(p.w_out_b, 1024, 1024, (u & 31) * 64, (u >> 5) * 64, wtob, 2048, tile); }
    }
    rmsnorm_bf16(p.xp, p.xs, T_PR, p.norm_w, (bf16_t*)(p.ws + WS_XN));
    for (int e = blockIdx.x * 512 + threadIdx.x; e < (64 + 32 + 8) * 128; e += gridDim.x * 512) {
        const int i = e & 127, r = e >> 7;
        const double inv = exp(-((double)i / 127.0) * 9.210340371976184);
        const double pos = r < 64 ? (double)r : r < 96 ? (double)((r - 64) * 64) : (double)(16384 + (r - 96));
        double sn, cs; sincos(pos * inv, &sn, &cs);
        f32x2* dst = (f32x2*)(p.ws + (r < 64 ? WS_TABR : r < 96 ? WS_TABC : WS_TABS)) + ((r < 64 ? r : r < 96 ? r - 64 : r - 96) * 128 + i);
        *dst = (f32x2){(float)cs, (float)sn};
    }
}

DI void phase_gdn_prep(const Params& p, unsigned char* smem) {
    float* ks = (float*)smem;
    float* vs = ks + 64 * 132;
    float* lowT = vs + 64 * 132;
    float* Gs = lowT + 64 * 68;
    float* Bs = Gs + 64;
    float* Es = Bs + 64;
    float* qs = Es + 64 + 64;
    float* solL = qs;
    const bf16_t* P0 = (const bf16_t*)(p.ws + WS_P0);
    const int tid = opaque_tid(), lane = tid & 63, wid = tid >> 6, hh = lane >> 5, l31 = lane & 31;
    for (int e = blockIdx.x * 512 + tid; e < (8 + 128) * 3 * 3072; e += gridDim.x * 512) {
        const int ch = e % 3072, r = (e / 3072) % 3, b = e / 9216;
        if (b < 8) p.out[O_GCP + (size_t)(b * 3 + r) * 3072 + ch] = bf2f(P0[(size_t)(b * 2048 + 2045 + r) * LDP0 + ch]);
        else { const int bb = b - 8; p.out[O_GCS + (size_t)(bb * 3 + r) * 3072 + ch] = bf2f(P0[(size_t)(T_PR + bb * 8 + 5 + r) * LDP0 + ch]); }
    }
    const int a_rg = tid / 96, a_cq = tid - a_rg * 96, a_sec = a_cq >> 5, a_c4 = (a_cq & 31) * 4, a_r0 = a_rg * 13;
    u32x2 xv[16];
#define GDN_LOAD_ROWS(it) do { const int n_ = (it) & 31, h_ = ((it) >> 5) & 7, b_ = (it) >> 8, col_ = a_sec * 1024 + h_ * 128 + a_c4; \
        _Pragma("unroll") for (int r = 0; r < 16; ++r) { const int rr = a_r0 + r - 3, tr = n_ * 64 + rr; \
            xv[r] = (a_rg < 5 && rr < 64 && tr >= 0) ? *(const u32x2*)(P0 + (size_t)(b_ * 2048 + tr) * LDP0 + col_) : (u32x2){0u, 0u}; } } while (0)
    if ((int)blockIdx.x < 2048) GDN_LOAD_ROWS((int)blockIdx.x);
    for (int item = blockIdx.x; item < 2048; item += gridDim.x) {
        const int n = item & 31, h = (item >> 5) & 7, b = item >> 8;
        const int tok0 = b * 2048 + n * 64;
        unsigned char* blk = p.ws + WS_GOP + (size_t)item * GOP_STRIDE;
        int tid_i = tid; asm volatile("" : "+v"(tid_i));
        const int tid = tid_i, lane = tid & 63, wid = tid >> 6, hh = lane >> 5, l31 = lane & 31;
        float braw = 0.f, araw = 0.f;
        if (wid == 0) { braw = bf2f(P0[(size_t)(tok0 + lane) * LDP0 + 4096 + h]); araw = bf2f(P0[(size_t)(tok0 + lane) * LDP0 + 4104 + h]); }
        bf16_t* o_nw = (bf16_t*)blk; bf16_t* o_qe = o_nw + 8192; bf16_t* o_kdT = o_qe + 8192; bf16_t* o_qkd = o_kdT + 8192; bf16_t* o_u0T = o_qkd + 4096;
        _Pragma("unroll") for (int rpA = 0; rpA <= ((PROBE_MASK >> 19) & 1); ++rpA)
        {
            const int rg = a_rg, sec = a_sec, c4 = a_c4, col = sec * 1024 + h * 128 + c4, r0 = a_r0;
            f32x4 w[4];
#pragma unroll
            for (int j = 0; j < 4; ++j) w[j] = *(const f32x4*)(p.conv_w + j * 3072 + col);
            float* dstb = (sec == 0 ? qs : sec == 1 ? ks : vs) + c4;
#pragma unroll
            for (int r = 0; r < 13; ++r) {
                float o0 = 0.f, o1 = 0.f, o2 = 0.f, o3 = 0.f;
#pragma unroll
                for (int j = 0; j < 4; ++j) { o0 += bflo(xv[r + j].x) * w[j].x; o1 += bfhi(xv[r + j].x) * w[j].y; o2 += bflo(xv[r + j].y) * w[j].z; o3 += bfhi(xv[r + j].y) * w[j].w; }
                o0 = silu_f(o0); o1 = silu_f(o1); o2 = silu_f(o2); o3 = silu_f(o3);
                float ss = row16_sum(o0 * o0 + o1 * o1 + o2 * o2 + o3 * o3);
                ss += __shfl_xor(ss, 16);
                float sc = 1.f;
                if (sec < 2) sc = rsqrtf(ss + 1e-6f) * (sec == 0 ? 0.08838834764831845f : 1.f);
                if (rg < 5 && r0 + r < 64) *(f32x4*)(dstb + (r0 + r) * 132) = (f32x4){o0 * sc, o1 * sc, o2 * sc, o3 * sc};
            }
        }
        if (wid == 0) {
            const float beta = 1.f / (1.f + expf(-braw));
            const float xx = araw + p.dt_bias[h];
            const float sp = xx > 20.f ? xx : log1pf(expf(xx));
            float g = -expf(p.a_log[h]) * sp;
#pragma unroll
            for (int d = 1; d < 64; d <<= 1) { const float t = __shfl_up(g, d); if (lane >= d) g += t; }
            Gs[lane] = g; Bs[lane] = beta; Es[lane] = expf(g);
        }
        lds_barrier();
        _Pragma("unroll") for (int rpC = 0; rpC <= ((PROBE_MASK >> 20) & 1); ++rpC) {
            const int which = wid >> 2, ti = (wid >> 1) & 1, tj = wid & 1;
            const float* Ap = (which ? qs : ks) + (32 * ti + l31) * 132 + 8 * hh;
            const float* Bp = ks + (32 * tj + l31) * 132 + 8 * hh;
            f32x16 acc;
#pragma unroll
            for (int i = 0; i < 16; ++i) acc[i] = 0.f;
            if (ti >= tj) {
#pragma unroll 2
                for (int k0 = 0; k0 < 128; k0 += 16) {
                    bf16x8 ah, al, bh, bl;
                    split8(*(const f32x4*)(Ap + k0), *(const f32x4*)(Ap + k0 + 4), ah, al);
                    split8(*(const f32x4*)(Bp + k0), *(const f32x4*)(Bp + k0 + 4), bh, bl);
                    acc = MFMA32(ah, bh, acc);
                    if (which == 0) { acc = MFMA32(ah, bl, acc); acc = MFMA32(al, bh, acc); }
                }
            }
            const int col = 32 * tj + l31; const float Gc = Gs[col];
#pragma unroll
            for (int i = 0; i < 16; ++i) {
                const int row = 32 * ti + crow(i, hh);
                const float dec = __expf(fminf(Gs[row] - Gc, 0.f));
                if (which == 0) lowT[col * 68 + row] = row > col ? Bs[row] * acc[i] * dec : 0.f;
                else { const int kk = col & 15; o_qkd[((((row >> 5) * 4 + (col >> 4)) * 64 + (row & 31) + 32 * ((kk >> 2) & 1)) << 3) + (kk & 3) + 4 * (kk >> 3)] = f2bf(row >= col ? acc[i] * dec : 0.f); }
            }
        }
        lds_barrier();
#pragma unroll
        for (int m = 0; m < 2; ++m) { const int e = tid + 512 * m, i = e >> 4, d0 = (e & 15) * 8; const float eg = Es[i]; const float* s = qs + i * 132 + d0;
            u32x2 w0, w1; w0.x = pk_bf16(s[0] * eg, s[1] * eg); w0.y = pk_bf16(s[2] * eg, s[3] * eg); w1.x = pk_bf16(s[4] * eg, s[5] * eg); w1.y = pk_bf16(s[6] * eg, s[7] * eg);
            bf16_t* fp = o_qe + ((((i >> 5) * 8 + (d0 >> 4)) * 64 + (i & 31)) << 3) + ((d0 >> 3) & 1) * 4;
            *(u32x2*)fp = w0; *(u32x2*)(fp + 32 * 8) = w1; }
        { const float GL = Gs[63];
#pragma unroll
          for (int m = 0; m < 2; ++m) { const int e = tid + 512 * m, d = e & 127, i0 = (e >> 7) * 8; float v[8];
#pragma unroll
            for (int j = 0; j < 8; ++j) v[j] = ks[(i0 + j) * 132 + d] * __expf(GL - Gs[i0 + j]);
            u32x2 w0, w1; w0.x = pk_bf16(v[0], v[1]); w0.y = pk_bf16(v[2], v[3]); w1.x = pk_bf16(v[4], v[5]); w1.y = pk_bf16(v[6], v[7]);
            bf16_t* fp = o_kdT + ((((d >> 5) * 4 + (i0 >> 4)) * 64 + (d & 31)) << 3) + ((i0 >> 3) & 1) * 4;
            *(u32x2*)fp = w0; *(u32x2*)(fp + 32 * 8) = w1; }
          if (tid == 0) *(float*)(blk + 73728) = expf(GL); }
        if (item + (int)gridDim.x < 2048) GDN_LOAD_ROWS(item + (int)gridDim.x);
        lds_barrier();
        _Pragma("unroll") for (int rpE = 0; rpE <= ((PROBE_MASK >> 18) & 1); ++rpE)
        {
            const int isk = wid >> 2, sl = wid & 3, c0 = sl * 32 + l31;
            const float* src = (isk ? ks : vs) + c0;
            f32x16 R[2];
#pragma unroll
            for (int rt = 0; rt < 2; ++rt)
#pragma unroll
                for (int i = 0; i < 16; ++i) { const int row = 32 * rt + crow(i, hh); R[rt][i] = Bs[row] * src[row * 132] * (isk ? Es[row] : 1.f); }
#pragma unroll
            for (int bI = 0; bI < 8; ++bI) {
                const int rt = bI >> 2, g = bI & 3;
                const int rA = 8 * bI + 4 * hh, rP = 8 * bI + 4 * (1 - hh);
                const float* tp = lowT + rA * 68 + rA;
                const float t10 = tp[1], t20 = tp[2], t30 = tp[3], t21 = tp[68 + 2], t31 = tp[68 + 3], t32 = tp[136 + 3];
                float a0 = R[rt][4 * g], a1 = R[rt][4 * g + 1], a2 = R[rt][4 * g + 2], a3 = R[rt][4 * g + 3];
                float x0 = a0, x1 = a1 - t10 * x0, x2 = a2 - t20 * x0 - t21 * x1, x3 = a3 - t30 * x0 - t31 * x1 - t32 * x2;
                const float y0 = __shfl_xor(x0, 32), y1 = __shfl_xor(x1, 32), y2 = __shfl_xor(x2, 32), y3 = __shfl_xor(x3, 32);
                const float* cq = lowT + rP * 68 + rA;
                a0 -= cq[0] * y0 + cq[68] * y1 + cq[136] * y2 + cq[204] * y3;
                a1 -= cq[1] * y0 + cq[68 + 1] * y1 + cq[136 + 1] * y2 + cq[204 + 1] * y3;
                a2 -= cq[2] * y0 + cq[68 + 2] * y1 + cq[136 + 2] * y2 + cq[204 + 2] * y3;
                a3 -= cq[3] * y0 + cq[68 + 3] * y1 + cq[136 + 3] * y2 + cq[204 + 3] * y3;
                x0 = a0; x1 = a1 - t10 * x0; x2 = a2 - t20 * x0 - t21 * x1; x3 = a3 - t30 * x0 - t31 * x1 - t32 * x2;
                if (isk) {
                    const int kk = c0 & 15; const float xs4[4] = {x0, x1, x2, x3};
#pragma unroll
                    for (int a = 0; a < 4; ++a) { const int row = rA + a;
                        o_nw[((((row >> 5) * 8 + (c0 >> 4)) * 64 + (row & 31) + 32 * ((kk >> 2) & 1)) << 3) + (kk & 3) + 4 * (kk >> 3)] = f2bf(-xs4[a]); }
                } else {
                    u32x2 w0; w0.x = pk_bf16(x0, x1); w0.y = pk_bf16(x2, x3);
                    *(u32x2*)(o_u0T + ((((sl * 2 + rt) * 64 + lane) << 4) + 4 * g)) = w0;
                }
                bf16x8 xh, xl; split4z(-x0, -x1, -x2, -x3, xh, xl);
#pragma unroll
                for (int rt2 = rt; rt2 < 2; ++rt2) {
                    if (rt2 == rt && g == 3) continue;
                    const float* ap = lowT + rA * 68 + 32 * rt2 + l31;
                    bf16x8 ah, al; split4z(ap[0], ap[68], ap[136], ap[204], ah, al);
                    R[rt2] = MFMA32(ah, xh, R[rt2]); R[rt2] = MFMA32(ah, xl, R[rt2]); R[rt2] = MFMA32(al, xh, R[rt2]);
                }
                __builtin_amdgcn_sched_barrier(0);
            }
        }
        lds_barrier();
    }
}

#define LDSV(off) (*(const LAS bf16x8*)(base + (off)))
DI void gdn_scan_prompt(const Params& p, int bh, unsigned char* smem) {
    LAS unsigned char* lds = (LAS unsigned char*)smem;
    const int tid = opaque_tid(), lane = tid & 63, wid = __builtin_amdgcn_readfirstlane(tid >> 6), hh = lane >> 5, l31 = lane & 31;
    const int h = bh & 7, b = bh >> 3, s = wid;
    const unsigned char* gblk = p.ws + WS_GOP + (size_t)bh * 32 * GOP_STRIDE;
    bf16_t* oraw = (bf16_t*)(p.ws + WS_ORAW);
    f32x16 S[4];
#pragma unroll
    for (int t = 0; t < 4; ++t)
#pragma unroll
        for (int i = 0; i < 16; ++i) S[t][i] = 0.f;
    unsigned voff16 = lane * 16; asm volatile("" : "+v"(voff16));
#define GDN_DMA(n, buf) do { const unsigned char* g_ = gblk + (size_t)(n) * GOP_STRIDE; _Pragma("unroll") for (int i_ = 0; i_ < 18; ++i_) { const int pc_ = (wid - 4) + 4 * i_; \
        __builtin_amdgcn_global_load_lds((const unsigned*)((g_ + pc_ * 1024) + voff16), (LAS unsigned*)(lds + (buf) * 73728 + pc_ * 1024), 16, 0, 0); } } while (0)
#define GDN_BAR() do { asm volatile("" ::: "memory"); __builtin_amdgcn_s_barrier(); asm volatile("" ::: "memory"); } while (0)
    lds_barrier();
#define GDN_PF(n) do { const unsigned char* g_ = gblk + (size_t)(n) * GOP_STRIDE; _Pragma("unroll") for (int i_ = 0; i_ < 18; ++i_) { const int pc_ = (wid - 4) + 4 * i_; \
        __builtin_amdgcn_global_load_lds((const unsigned*)((g_ + pc_ * 1024) + voff16), (LAS unsigned*)(lds + 148480 + (wid - 4) * 1024), 16, 0, 0); } } while (0)
    if (wid >= 4) { GDN_DMA(0, 0); GDN_PF(1); GDN_PF(2); asm volatile("s_waitcnt vmcnt(0)" ::: "memory"); }
    GDN_BAR();
    for (int n = 0; n < 32; ++n) {
        if (wid >= 4 && n + 1 < 32) GDN_DMA(n + 1, (n + 1) & 1);
        if (wid >= 4 && n + 3 < 32) GDN_PF(n + 3);
        if (wid < 4) {
            LAS unsigned char* base = lds + (n & 1) * 73728 + lane * 16;
            const float dl = *(const float*)(gblk + (size_t)n * GOP_STRIDE + 73728);
            bf16x8 Ub[4];
            {
                f32x16 U[2];
#pragma unroll
                for (int rt = 0; rt < 2; ++rt) {
#pragma unroll
                    for (int g = 0; g < 2; ++g) { const u32x4 v = *(const LAS u32x4*)(lds + (n & 1) * 73728 + 57344 + (((s * 2 + rt) * 64 + lane) << 5) + 16 * g);
                        U[rt][8 * g] = bflo(v.x); U[rt][8 * g + 1] = bfhi(v.x); U[rt][8 * g + 2] = bflo(v.y); U[rt][8 * g + 3] = bfhi(v.y);
                        U[rt][8 * g + 4] = bflo(v.z); U[rt][8 * g + 5] = bfhi(v.z); U[rt][8 * g + 6] = bflo(v.w); U[rt][8 * g + 7] = bfhi(v.w); }
                }
#pragma unroll
                for (int t = 0; t < 4; ++t)
#pragma unroll
                    for (int s2 = 0; s2 < 2; ++s2) {
                        const bf16x8 sb = packB(S[t], s2);
#pragma unroll
                        for (int rt = 0; rt < 2; ++rt) U[rt] = MFMA32(LDSV((rt * 8 + 2 * t + s2) * 1024), sb, U[rt]);
                    }
#pragma unroll
                for (int kc = 0; kc < 4; ++kc) Ub[kc] = packB(U[kc >> 1], kc & 1);
            }
            f32x16 O[2];
#pragma unroll
            for (int rt = 0; rt < 2; ++rt)
#pragma unroll
                for (int i = 0; i < 16; ++i) O[rt][i] = 0.f;
#pragma unroll
            for (int t = 0; t < 4; ++t)
#pragma unroll
                for (int s2 = 0; s2 < 2; ++s2) {
                    const bf16x8 sb = packB(S[t], s2);
#pragma unroll
                    for (int rt = 0; rt < 2; ++rt) O[rt] = MFMA32(LDSV(16384 + (rt * 8 + 2 * t + s2) * 1024), sb, O[rt]);
                }
#pragma unroll
            for (int rt = 0; rt < 2; ++rt)
#pragma unroll
                for (int kc = 0; kc < 2 * rt + 2; ++kc) O[rt] = MFMA32(LDSV(49152 + (rt * 4 + kc) * 1024), Ub[kc], O[rt]);
            const size_t tok0 = (size_t)b * 2048 + n * 64;
#pragma unroll
            for (int rt = 0; rt < 2; ++rt)
#pragma unroll
                for (int i = 0; i < 16; ++i) oraw[(tok0 + 32 * rt + crow(i, hh)) * 1024 + h * 128 + 32 * s + l31] = f2bf(O[rt][i]);
#pragma unroll
            for (int t = 0; t < 4; ++t) {
#pragma unroll
                for (int i = 0; i < 16; ++i) S[t][i] *= dl;
#pragma unroll
                for (int kc = 0; kc < 4; ++kc) S[t] = MFMA32(LDSV(32768 + (t * 4 + kc) * 1024), Ub[kc], S[t]);
            }
        }
        if (wid >= 4) { if (n + 3 < 32) asm volatile("s_waitcnt vmcnt(18)" ::: "memory"); else asm volatile("s_waitcnt vmcnt(0)" ::: "memory"); }
        else asm volatile("s_waitcnt lgkmcnt(0)" ::: "memory");
        GDN_BAR();
    }
    lds_barrier();
#undef GDN_BAR
#undef GDN_PF
#undef GDN_DMA
    if (wid < 4) {
        float* so = p.out + O_GSP + (size_t)bh * 16384;
#pragma unroll
        for (int t = 0; t < 4; ++t)
#pragma unroll
            for (int i = 0; i < 16; ++i) so[(32 * t + crow(i, hh)) * 128 + 32 * s + l31] = S[t][i];
    }
}

DI void gdn_sample_item(const Params& p, int item, unsigned char* smem) {
    float* raw = (float*)smem;
    float* nwT = raw + 3072;
    float* qeT = nwT + 1024;
    float* kdT = qeT + 1024;
    float* u0 = kdT + 1024;
    float* lowm = u0 + 1024;
    float* qkm = lowm + 64;
    float* Gs = qkm + 64;
    float* part = Gs + 32;
    const bf16_t* P0 = (const bf16_t*)(p.ws + WS_P0);
    int tid_ = threadIdx.x; asm volatile("" : "+v"(tid_));
    const int tid = tid_, lane = tid & 63, wid = tid >> 6;
    const int h = item & 7, b = item >> 3, tok0 = T_PR + b * 8;
#pragma unroll
    for (int m = 0; m < 6; ++m) {
        const int e = tid + 512 * m, row = e / 384, c3 = e - row * 384, sec = c3 >> 7, col = sec * 1024 + h * 128 + (c3 & 127);
        float o = 0.f;
#pragma unroll
        for (int j = 0; j < 4; ++j) { const int tr = row - 3 + j;
            const float x = tr >= 0 ? bf2f(P0[(size_t)(tok0 + tr) * LDP0 + col]) : p.st_conv[(size_t)(b * 3 + (3 + tr)) * 3072 + col];
            o += x * p.conv_w[j * 3072 + col]; }
        raw[sec * 1024 + row * 128 + (c3 & 127)] = silu_f(o);
    }
    if (tid < 8) {
        const float braw = bf2f(P0[(size_t)(tok0 + tid) * LDP0 + 4096 + h]), araw = bf2f(P0[(size_t)(tok0 + tid) * LDP0 + 4104 + h]);
        const float xx = araw + p.dt_bias[h]; const float sp = xx > 20.f ? xx : log1pf(expf(xx));
        Gs[16 + tid] = -expf(p.a_log[h]) * sp;
        Gs[8 + tid] = 1.f / (1.f + expf(-braw));
    }
    lds_barrier();
    { float q0 = raw[wid * 128 + lane], q1 = raw[wid * 128 + 64 + lane], k0 = raw[1024 + wid * 128 + lane], k1 = raw[1024 + wid * 128 + 64 + lane];
      const float sq = wave_sum(q0 * q0 + q1 * q1), sk = wave_sum(k0 * k0 + k1 * k1);
      const float cq = rsqrtf(sq + 1e-6f) * 0.08838834764831845f, ck = rsqrtf(sk + 1e-6f);
      raw[wid * 128 + lane] = q0 * cq; raw[wid * 128 + 64 + lane] = q1 * cq; raw[1024 + wid * 128 + lane] = k0 * ck; raw[1024 + wid * 128 + 64 + lane] = k1 * ck; }
    if (tid == 0) { float a = 0.f; for (int i = 0; i < 8; ++i) { a += Gs[16 + i]; Gs[i] = a; } }
    lds_barrier();
    if (tid < 8) Gs[24 + tid] = expf(Gs[tid]);
    { const int i = wid; const float ki0 = raw[1024 + i * 128 + lane], ki1 = raw[1024 + i * 128 + 64 + lane], qi0 = raw[i * 128 + lane], qi1 = raw[i * 128 + 64 + lane];
      for (int j = 0; j <= i; ++j) { const float kj0 = raw[1024 + j * 128 + lane], kj1 = raw[1024 + j * 128 + 64 + lane];
          const float kk = wave_sum(ki0 * kj0 + ki1 * kj1), qk = wave_sum(qi0 * kj0 + qi1 * kj1);
          const float dec = expf(Gs[i] - Gs[j]);
          if (lane == 0) { lowm[i * 8 + j] = (j < i) ? Gs[8 + i] * kk * dec : 0.f; qkm[i * 8 + j] = qk * dec; } } }
    lds_barrier();
    if (tid < 256) {
        const int isk = tid >> 7, cc = tid & 127; float sol[8];
#pragma unroll
        for (int i = 0; i < 8; ++i) { float r = Gs[8 + i] * (isk ? Gs[24 + i] * raw[1024 + i * 128 + cc] : raw[2048 + i * 128 + cc]);
#pragma unroll
            for (int j = 0; j < i; ++j) r -= lowm[i * 8 + j] * sol[j];
            sol[i] = r; }
#pragma unroll
        for (int i = 0; i < 8; ++i) { if (isk) nwT[cc * 8 + i] = -sol[i]; else u0[i * 128 + cc] = sol[i]; }
    } else {
        const int t2 = tid - 256, which = t2 >> 7, d = t2 & 127;
#pragma unroll
        for (int i = 0; i < 8; ++i) { if (which == 0) qeT[d * 8 + i] = raw[i * 128 + d] * Gs[24 + i]; else kdT[d * 8 + i] = raw[1024 + i * 128 + d] * expf(Gs[7] - Gs[i]); }
    }
    lds_barrier();
    const int dv = tid & 127, qt = tid >> 7;
    const float* S0 = p.st_gdn + (size_t)item * 16384;
    float pu[8], po[8];
#pragma unroll
    for (int c = 0; c < 8; ++c) { pu[c] = 0.f; po[c] = 0.f; }
#pragma unroll 1
    for (int r0 = 0; r0 < 32; r0 += 16) {
        float sv[16];
#pragma unroll
        for (int r = 0; r < 16; ++r) sv[r] = S0[(32 * qt + r0 + r) * 128 + dv];
#pragma unroll
        for (int r = 0; r < 16; ++r) { const int dk = 32 * qt + r0 + r;
            const f32x4 w0 = *(const f32x4*)(nwT + dk * 8), w1 = *(const f32x4*)(nwT + dk * 8 + 4), e0 = *(const f32x4*)(qeT + dk * 8), e1 = *(const f32x4*)(qeT + dk * 8 + 4);
            const float s = sv[r];
            pu[0] += w0.x * s; pu[1] += w0.y * s; pu[2] += w0.z * s; pu[3] += w0.w * s; pu[4] += w1.x * s; pu[5] += w1.y * s; pu[6] += w1.z * s; pu[7] += w1.w * s;
            po[0] += e0.x * s; po[1] += e0.y * s; po[2] += e0.z * s; po[3] += e0.w * s; po[4] += e1.x * s; po[5] += e1.y * s; po[6] += e1.z * s; po[7] += e1.w * s; }
    }
#pragma unroll
    for (int c = 0; c < 8; ++c) { part[(qt * 8 + c) * 128 + dv] = pu[c]; part[4096 + (qt * 8 + c) * 128 + dv] = po[c]; }
    lds_barrier();
    float u[8];
#pragma unroll
    for (int c = 0; c < 8; ++c) u[c] = u0[c * 128 + dv] + part[c * 128 + dv] + part[(8 + c) * 128 + dv] + part[(16 + c) * 128 + dv] + part[(24 + c) * 128 + dv];
    if (qt == 0) {
        bf16_t* oraw = (bf16_t*)(p.ws + WS_ORAW);
#pragma unroll
        for (int c = 0; c < 8; ++c) { float o = part[4096 + c * 128 + dv] + part[4096 + (8 + c) * 128 + dv] + part[4096 + (16 + c) * 128 + dv] + part[4096 + (24 + c) * 128 + dv];
#pragma unroll
            for (int j = 0; j <= c; ++j) o += qkm[c * 8 + j] * u[j];
            oraw[(size_t)(tok0 + c) * 1024 + h * 128 + dv] = f2bf(o); }
    }
    { const float dl = Gs[24 + 7]; float* So = p.out + O_GSS + (size_t)item * 16384;
#pragma unroll 1
      for (int r0 = 0; r0 < 32; r0 += 16) {
          float sv[16];
#pragma unroll
          for (int r = 0; r < 16; ++r) sv[r] = S0[(32 * qt + r0 + r) * 128 + dv];
#pragma unroll
          for (int r = 0; r < 16; ++r) { const int dk = 32 * qt + r0 + r; const f32x4 k0 = *(const f32x4*)(kdT + dk * 8), k1 = *(const f32x4*)(kdT + dk * 8 + 4);
              So[dk * 128 + dv] = dl * sv[r] + k0.x * u[0] + k0.y * u[1] + k0.z * u[2] + k0.w * u[3] + k1.x * u[4] + k1.y * u[5] + k1.z * u[6] + k1.w * u[7]; }
      } }
    lds_barrier();
}
DI void phase_gdn_scan(const Params& p, unsigned char* smem) {
    const int nscan = 64;
    if ((int)blockIdx.x < nscan) {
        _Pragma("unroll") for (int rp = 0; rp <= ((PROBE_MASK >> 13) & 1); ++rp)
        for (int bh = blockIdx.x; bh < 64; bh += nscan) gdn_scan_prompt(p, bh, smem);
    } else {
        _Pragma("unroll") for (int rp = 0; rp <= ((PROBE_MASK >> 14) & 1); ++rp)
        for (int item = blockIdx.x - nscan; item < 1024; item += gridDim.x - nscan) gdn_sample_item(p, item, smem);
    }
}

DI void phase_gdn_gate(const Params& p) {
    const int lane = threadIdx.x & 63, gw = blockIdx.x * 8 + (threadIdx.x >> 6), nw = gridDim.x * 8;
    const bf16_t* oraw = (const bf16_t*)(p.ws + WS_ORAW); const bf16_t* P0 = (const bf16_t*)(p.ws + WS_P0); bf16_t* og = (bf16_t*)(p.ws + WS_OG);
    for (int tok = gw; tok < T_TOK; tok += nw) {
        const u32x4 a0 = *(const u32x4*)(oraw + (size_t)tok * 1024 + 16 * lane), a1 = *(const u32x4*)(oraw + (size_t)tok * 1024 + 16 * lane + 8);
        const u32x4 z0 = *(const u32x4*)(P0 + (size_t)tok * LDP0 + 3072 + 16 * lane), z1 = *(const u32x4*)(P0 + (size_t)tok * LDP0 + 3072 + 16 * lane + 8);
        float o[16], z[16];
        const unsigned au[8] = {a0.x, a0.y, a0.z, a0.w, a1.x, a1.y, a1.z, a1.w}, zu[8] = {z0.x, z0.y, z0.z, z0.w, z1.x, z1.y, z1.z, z1.w};
        float ss = 0.f;
#pragma unroll
        for (int i = 0; i < 8; ++i) { o[2 * i] = bflo(au[i]); o[2 * i + 1] = bfhi(au[i]); z[2 * i] = bflo(zu[i]); z[2 * i + 1] = bfhi(zu[i]); ss += o[2 * i] * o[2 * i] + o[2 * i + 1] * o[2 * i + 1]; }
        ss += __shfl_xor(ss, 1); ss += __shfl_xor(ss, 2); ss += __shfl_xor(ss, 4);
        const float rstd = rsqrtf(ss * (1.f / 128.f) + 1e-6f);
        const int d0 = (16 * lane) & 127;
        unsigned r[8];
#pragma unroll
        for (int i = 0; i < 8; ++i) { const float v0 = o[2 * i] * rstd * p.onorm_a[d0 + 2 * i] * silu_f(z[2 * i]), v1 = o[2 * i + 1] * rstd * p.onorm_a[d0 + 2 * i + 1] * silu_f(z[2 * i + 1]); r[i] = pk_bf16(v0, v1); }
        *(u32x4*)(og + (size_t)tok * 1024 + 16 * lane) = (u32x4){r[0], r[1], r[2], r[3]};
        *(u32x4*)(og + (size_t)tok * 1024 + 16 * lane + 8) = (u32x4){r[4], r[5], r[6], r[7]};
    }
}

DI float ret_lg(int h) { return log1pf(-exp2f(-5.f - (float)h)); }
DI void rot_angle(double pos, double inv, float& sn, float& cs) {
    const double rev = pos * inv * 0.15915494309189535; const float fr = (float)(rev - rint(rev));
    sincosf(fr * 6.283185307179586f, &sn, &cs);
}
DI void phase_ret_prep(const Params& p, unsigned char* smem) {
    bf16_t* qr = (bf16_t*)smem;
    bf16_t* kr = qr + 64 * 264;
    bf16_t* vs = kr + 64 * 264;
    const bf16_t* P1 = (const bf16_t*)(p.ws + WS_P1);
    const f32x2* tabR = (const f32x2*)(p.ws + WS_TABR); const f32x2* tabC = (const f32x2*)(p.ws + WS_TABC);
    const int tid = opaque_tid(), lane = tid & 63, wid = tid >> 6, hh = lane >> 5, l31 = lane & 31;
    for (int item = blockIdx.x; item < 1024; item += gridDim.x) {
        const int n = item & 31, h = (item >> 5) & 3, b = item >> 7;
        const int tok0 = b * 2048 + n * 64;
        const float lg = ret_lg(h);
        unsigned char* blk = p.ws + WS_ROP + (size_t)item * ROP_STRIDE;
        bf16_t* o_qd = (bf16_t*)blk; bf16_t* o_kdT = o_qd + 16384; bf16_t* o_qkD = o_kdT + 16384; bf16_t* o_vT = o_qkD + 4096;
#pragma unroll
        for (int m = 0; m < 2; ++m) {
            const int e = tid + 512 * m, row = e >> 4, i0 = (e & 15) * 8;
            const bf16_t* src = P1 + (size_t)(tok0 + row) * LDP1 + h * 256 + i0;
            const u32x4 q1 = *(const u32x4*)src, q2 = *(const u32x4*)(src + 128), k1 = *(const u32x4*)(src + 1024), k2 = *(const u32x4*)(src + 1152);
            const unsigned q1u[4] = {q1.x, q1.y, q1.z, q1.w}, q2u[4] = {q2.x, q2.y, q2.z, q2.w}, k1u[4] = {k1.x, k1.y, k1.z, k1.w}, k2u[4] = {k2.x, k2.y, k2.z, k2.w};
            float qa[8], qb[8], ka[8], kb[8];
#pragma unroll
            for (int j = 0; j < 8; ++j) {
                const f32x2 tr = tabR[row * 128 + i0 + j], tc = tabC[n * 128 + i0 + j];
                const float cs = tc.x * tr.x - tc.y * tr.y, sn = tc.y * tr.x + tc.x * tr.y;
                const float x1 = (j & 1) ? bfhi(q1u[j >> 1]) : bflo(q1u[j >> 1]), x2 = (j & 1) ? bfhi(q2u[j >> 1]) : bflo(q2u[j >> 1]);
                const float y1 = (j & 1) ? bfhi(k1u[j >> 1]) : bflo(k1u[j >> 1]), y2 = (j & 1) ? bfhi(k2u[j >> 1]) : bflo(k2u[j >> 1]);
                qa[j] = x1 * cs - x2 * sn; qb[j] = x1 * sn + x2 * cs;
                ka[j] = (y1 * cs - y2 * sn) * 0.0625f; kb[j] = (y1 * sn + y2 * cs) * 0.0625f;
            }
            const float qdec = expf(lg * (float)(row + 1));
            u32x4 w;
            w.x = pk_bf16(qa[0], qa[1]); w.y = pk_bf16(qa[2], qa[3]); w.z = pk_bf16(qa[4], qa[5]); w.w = pk_bf16(qa[6], qa[7]); *(u32x4*)(qr + row * 264 + i0) = w;
            w.x = pk_bf16(qb[0], qb[1]); w.y = pk_bf16(qb[2], qb[3]); w.z = pk_bf16(qb[4], qb[5]); w.w = pk_bf16(qb[6], qb[7]); *(u32x4*)(qr + row * 264 + 128 + i0) = w;
            w.x = pk_bf16(ka[0], ka[1]); w.y = pk_bf16(ka[2], ka[3]); w.z = pk_bf16(ka[4], ka[5]); w.w = pk_bf16(ka[6], ka[7]); *(u32x4*)(kr + row * 264 + i0) = w;
            w.x = pk_bf16(kb[0], kb[1]); w.y = pk_bf16(kb[2], kb[3]); w.z = pk_bf16(kb[4], kb[5]); w.w = pk_bf16(kb[6], kb[7]); *(u32x4*)(kr + row * 264 + 128 + i0) = w;
            { u32x2 w0, w1; bf16_t* fp = o_qd + ((((row >> 5) * 16 + (i0 >> 4)) * 64 + (row & 31)) << 3) + ((i0 >> 3) & 1) * 4;
              w0.x = pk_bf16(qa[0] * qdec, qa[1] * qdec); w0.y = pk_bf16(qa[2] * qdec, qa[3] * qdec); w1.x = pk_bf16(qa[4] * qdec, qa[5] * qdec); w1.y = pk_bf16(qa[6] * qdec, qa[7] * qdec);
              *(u32x2*)fp = w0; *(u32x2*)(fp + 32 * 8) = w1;
              w0.x = pk_bf16(qb[0] * qdec, qb[1] * qdec); w0.y = pk_bf16(qb[2] * qdec, qb[3] * qdec); w1.x = pk_bf16(qb[4] * qdec, qb[5] * qdec); w1.y = pk_bf16(qb[6] * qdec, qb[7] * qdec);
              *(u32x2*)(fp + 8 * 64 * 8) = w0; *(u32x2*)(fp + 8 * 64 * 8 + 32 * 8) = w1; }
        }
        lds_barrier();
        if (wid < 4) {
            const int ti = wid >> 1, tj = wid & 1;
            f32x16 acc;
#pragma unroll
            for (int i = 0; i < 16; ++i) acc[i] = 0.f;
            if (ti >= tj) {
#pragma unroll 4
                for (int ksp = 0; ksp < 16; ++ksp)
                    acc = MFMA32(ld16(qr + (32 * ti + l31) * 264 + 16 * ksp + 8 * hh), ld16(kr + (32 * tj + l31) * 264 + 16 * ksp + 8 * hh), acc);
            }
            const int col = 32 * tj + l31;
#pragma unroll
            for (int i = 0; i < 16; ++i) { const int row = 32 * ti + crow(i, hh);
                o_qkD[((((row >> 5) * 4 + (col >> 4)) * 64 + (row & 31) + 32 * ((col >> 3) & 1)) << 3) + (col & 7)] = f2bf(row >= col ? acc[i] * __expf(lg * (float)(row - col)) : 0.f); }
        } else {
            const int dk = tid - 256;
#pragma unroll
            for (int i0 = 0; i0 < 64; i0 += 8) { float v[8];
#pragma unroll
                for (int j = 0; j < 8; ++j) v[j] = bf2f(kr[(i0 + j) * 264 + dk]) * __expf(lg * (float)(63 - i0 - j));
                u32x4 w; w.x = pk_bf16(v[0], v[1]); w.y = pk_bf16(v[2], v[3]); w.z = pk_bf16(v[4], v[5]); w.w = pk_bf16(v[6], v[7]);
                *(u32x4*)(o_kdT + ((((dk >> 5) * 4 + (i0 >> 4)) * 64 + (dk & 31) + 32 * ((i0 >> 3) & 1)) << 3)) = w; }
        }
        lds_barrier();
    }
}

DI void ret_scan_prompt(const Params& p, int item, unsigned char* smem) {
    LAS unsigned char* lds = (LAS unsigned char*)smem;
    const int tid = opaque_tid(), lane = tid & 63, wid = __builtin_amdgcn_readfirstlane(tid >> 6), hh = lane >> 5, l31 = lane & 31;
    const int half = item & 1, bh = item >> 1, h = bh & 3, b = bh >> 2, s = half * 8 + wid;
    const float sdec = expf(ret_lg(h) * 64.f);
    const unsigned char* gblk = p.ws + WS_ROP + (size_t)bh * 32 * ROP_STRIDE;
    bf16_t* oraw = (bf16_t*)(p.ws + WS_ORAW);
    LAS unsigned char* base = lds + lane * 16;
    f32x16 S[8];
#pragma unroll
    for (int t = 0; t < 8; ++t)
#pragma unroll
        for (int i = 0; i < 16; ++i) S[t][i] = 0.f;
    unsigned voff16 = lane * 16; asm volatile("" : "+v"(voff16));
    unsigned vrow_off = (lane >> 5) * (LDP1 * 2) + (lane & 31) * 16; asm volatile("" : "+v"(vrow_off));
#define RET_CP(goff, loff, npc) do { _Pragma("unroll") for (int i_ = 0; i_ < (npc); ++i_) { const int pc_ = wid + 8 * i_; \
        __builtin_amdgcn_global_load_lds((const unsigned*)((g_ + (goff) + pc_ * 1024) + voff16), (LAS unsigned*)(lds + (loff) + pc_ * 1024), 16, 0, 0); } } while (0)
#define RET_DMA_V(n) do { const unsigned char* gv_ = (const unsigned char*)(p.ws + WS_P1) + ((size_t)(b * 2048 + (n) * 64) * LDP1 + 2048 + h * 512 + half * 256) * 2; \
        _Pragma("unroll") for (int i_ = 0; i_ < 4; ++i_) { const int pc_ = wid + 8 * i_; \
        __builtin_amdgcn_global_load_lds((const unsigned*)((gv_ + (size_t)pc_ * (2 * LDP1 * 2)) + vrow_off), (LAS unsigned*)(lds + 73728 + ((n) & 1) * 32768 + pc_ * 1024), 16, 0, 0); } } while (0)
#define RET_DMA_A(n) do { const unsigned char* g_ = gblk + (size_t)(n) * ROP_STRIDE; RET_CP(0, 0, 4); RET_CP(65536, 32768, 1); RET_DMA_V(n); } while (0)
#define RET_DMA_B(n) do { const unsigned char* g_ = gblk + (size_t)(n) * ROP_STRIDE; RET_CP(32768, 40960, 4); } while (0)
    lds_barrier();
    RET_DMA_A(0);
    asm volatile("s_waitcnt vmcnt(0)" ::: "memory"); lds_barrier();
    for (int n = 0; n < 32; ++n) {
        RET_DMA_B(n);
        f32x16 O[2];
#pragma unroll
        for (int rt = 0; rt < 2; ++rt)
#pragma unroll
            for (int i = 0; i < 16; ++i) O[rt][i] = 0.f;
        const LAS unsigned short* vcol = (const LAS unsigned short*)(lds + 73728 + (n & 1) * 32768 + (wid * 32 + l31) * 2 + hh * (8 * 512));
#define RET_VFRAG(kc) ({ const LAS unsigned short* q_ = vcol + (kc) * (16 * 256); \
        u32x4 w_; w_.x = q_[0] | ((unsigned)q_[256] << 16); w_.y = q_[512] | ((unsigned)q_[768] << 16); w_.z = q_[1024] | ((unsigned)q_[1280] << 16); w_.w = q_[1536] | ((unsigned)q_[1792] << 16); \
        __builtin_bit_cast(bf16x8, w_); })
#pragma unroll
        for (int t = 0; t < 8; ++t)
#pragma unroll
            for (int s2 = 0; s2 < 2; ++s2) {
                const bf16x8 sb = packB(S[t], s2);
#pragma unroll
                for (int rt = 0; rt < 2; ++rt) O[rt] = MFMA32(LDSV((rt * 16 + 2 * t + s2) * 1024), sb, O[rt]);
                if (s2 == 1 && (t & 1)) __builtin_amdgcn_sched_barrier(0);
            }
#pragma unroll
        for (int kc = 0; kc < 4; ++kc) { const bf16x8 vb = RET_VFRAG(kc);
#pragma unroll
            for (int rt = (kc >> 1); rt < 2; ++rt) O[rt] = MFMA32(LDSV(32768 + (rt * 4 + kc) * 1024), vb, O[rt]); }
        const size_t tok0 = (size_t)b * 2048 + n * 64;
#pragma unroll
        for (int rt = 0; rt < 2; ++rt)
#pragma unroll
            for (int i = 0; i < 16; ++i) oraw[(tok0 + 32 * rt + crow(i, hh)) * 2048 + h * 512 + 32 * s + l31] = f2bf(O[rt][i]);
        asm volatile("s_waitcnt vmcnt(0)" ::: "memory"); lds_barrier();
        if (n + 1 < 32) RET_DMA_A(n + 1);
        bf16x8 Vb[4];
#pragma unroll
        for (int kc = 0; kc < 4; ++kc) Vb[kc] = RET_VFRAG(kc);
#pragma unroll
        for (int t = 0; t < 8; ++t) {
#pragma unroll
            for (int i = 0; i < 16; ++i) S[t][i] *= sdec;
#pragma unroll
            for (int kc = 0; kc < 4; ++kc) S[t] = MFMA32(LDSV(40960 + (t * 4 + kc) * 1024), Vb[kc], S[t]);
            if (t & 1) __builtin_amdgcn_sched_barrier(0);
        }
        asm volatile("s_waitcnt vmcnt(0)" ::: "memory"); lds_barrier();
    }
#undef RET_VFRAG
#undef RET_DMA_V
#undef RET_CP
#undef RET_DMA_A
#undef RET_DMA_B
    float* so = p.out + O_RP + (size_t)bh * 131072;
#pragma unroll
    for (int t = 0; t < 8; ++t)
#pragma unroll
        for (int i = 0; i < 16; ++i) so[(32 * t + crow(i, hh)) * 512 + 32 * s + l31] = S[t][i];
}
DI void ret_sample_item(const Params& p, int item, unsigned char* smem) {
    float* qT = (float*)smem;
    float* kT = qT + 2048;
    float* qraw = kT + 2048;
    float* kraw = qraw + 2048;
    float* qkm = kraw + 2048;
    const bf16_t* P1 = (const bf16_t*)(p.ws + WS_P1);
    int tid_ = threadIdx.x; asm volatile("" : "+v"(tid_));
    const int tid = tid_, lane = tid & 63, wid = tid >> 6;
    const int h = item & 3, b = item >> 2, tok0 = T_PR + b * 8;
    const float lg = ret_lg(h);
#pragma unroll
    for (int m = 0; m < 2; ++m) {
        const int e = tid + 512 * m, row = e >> 7, i = e & 127;
        const f32x2 tsv = ((const f32x2*)(p.ws + WS_TABS))[row * 128 + i]; const float cs = tsv.x, sn = tsv.y;
        const bf16_t* src = P1 + (size_t)(tok0 + row) * LDP1 + h * 256 + i;
        const float x1 = bf2f(src[0]), x2 = bf2f(src[128]), y1 = bf2f(src[1024]), y2 = bf2f(src[1152]);
        const float qa = x1 * cs - x2 * sn, qb = x1 * sn + x2 * cs, ka = (y1 * cs - y2 * sn) * 0.0625f, kb = (y1 * sn + y2 * cs) * 0.0625f;
        const float qdec = expf(lg * (float)(row + 1)), kdec = expf(lg * (float)(7 - row));
        qraw[row * 256 + i] = qa; qraw[row * 256 + 128 + i] = qb; kraw[row * 256 + i] = ka; kraw[row * 256 + 128 + i] = kb;
        qT[i * 8 + row] = qa * qdec; qT[(128 + i) * 8 + row] = qb * qdec; kT[i * 8 + row] = ka * kdec; kT[(128 + i) * 8 + row] = kb * kdec;
    }
    lds_barrier();
    { const int i = wid;
      for (int j = 0; j <= i; ++j) { float a = 0.f;
#pragma unroll
          for (int q = 0; q < 4; ++q) a += qraw[i * 256 + lane + 64 * q] * kraw[j * 256 + lane + 64 * q];
          a = wave_sum(a);
          if (lane == 0) qkm[i * 8 + j] = a * expf(lg * (float)(i - j)); } }
    lds_barrier();
    float* red = (float*)(smem + 40960);
    float* vsh = (float*)(smem + 106496);
    const int dv4 = tid & 127, dkq = tid >> 7;
    f32x4 v[8], ao[8];
#pragma unroll
    for (int c = 0; c < 8; ++c) { const u32x2 vv = *(const u32x2*)(P1 + (size_t)(tok0 + c) * LDP1 + 2048 + h * 512 + 4 * dv4);
        v[c] = (f32x4){bflo(vv.x), bfhi(vv.x), bflo(vv.y), bfhi(vv.y)}; ao[c] = (f32x4){0.f, 0.f, 0.f, 0.f};
        if (dkq == 0) *(f32x4*)(vsh + c * 512 + 4 * dv4) = v[c]; }
    const float sdec = expf(lg * 8.f);
    const float* S0 = p.st_ret + (size_t)item * 131072 + 4 * dv4; float* So = p.out + O_RS + (size_t)item * 131072 + 4 * dv4;
#pragma unroll 1
    for (int dk0 = 64 * dkq; dk0 < 64 * dkq + 64; dk0 += 16) {
        f32x4 sv[16];
#pragma unroll
        for (int r = 0; r < 16; ++r) sv[r] = __builtin_nontemporal_load((const f32x4*)(S0 + (size_t)(dk0 + r) * 512));
#pragma unroll
        for (int r = 0; r < 16; ++r) { const int dk = dk0 + r;
            const f32x4 q0 = *(const f32x4*)(qT + dk * 8), q1 = *(const f32x4*)(qT + dk * 8 + 4), k0 = *(const f32x4*)(kT + dk * 8), k1 = *(const f32x4*)(kT + dk * 8 + 4);
            const f32x4 s = sv[r];
            ao[0] += q0.x * s; ao[1] += q0.y * s; ao[2] += q0.z * s; ao[3] += q0.w * s; ao[4] += q1.x * s; ao[5] += q1.y * s; ao[6] += q1.z * s; ao[7] += q1.w * s;
            const f32x4 sn = sdec * s + k0.x * v[0] + k0.y * v[1] + k0.z * v[2] + k0.w * v[3] + k1.x * v[4] + k1.y * v[5] + k1.z * v[6] + k1.w * v[7];
            __builtin_nontemporal_store(sn, (f32x4*)(So + (size_t)dk * 512)); }
    }
#pragma unroll
    for (int c = 0; c < 8; ++c) *(f32x4*)(red + (dkq * 8 + c) * 512 + 4 * dv4) = ao[c];
    lds_barrier();
    bf16_t* oraw = (bf16_t*)(p.ws + WS_ORAW);
    { const int dv = tid; float vc[8];
#pragma unroll
      for (int c = 0; c < 8; ++c) vc[c] = vsh[c * 512 + dv];
#pragma unroll
      for (int c = 0; c < 8; ++c) { float o = red[c * 512 + dv] + red[(8 + c) * 512 + dv] + red[(16 + c) * 512 + dv] + red[(24 + c) * 512 + dv];
#pragma unroll
          for (int j = 0; j <= c; ++j) o += qkm[c * 8 + j] * vc[j];
          oraw[(size_t)(tok0 + c) * 2048 + h * 512 + dv] = f2bf(o); } }
    lds_barrier();
}
DI void phase_ret_scan(const Params& p, unsigned char* smem) {
    const int nscan = 64;
    if ((int)blockIdx.x < nscan) {
        _Pragma("unroll") for (int rp = 0; rp <= ((PROBE_MASK >> 15) & 1); ++rp)
        for (int item = blockIdx.x; item < 64; item += nscan) ret_scan_prompt(p, item, smem);
    } else {
        _Pragma("unroll") for (int rp = 0; rp <= ((PROBE_MASK >> 16) & 1); ++rp)
        for (int item = blockIdx.x - nscan; item < 512; item += gridDim.x - nscan) ret_sample_item(p, item, smem);
    }
}

DI void phase_ret_gate(const Params& p) {
    const int lane = threadIdx.x & 63, gw = blockIdx.x * 8 + (threadIdx.x >> 6), nw = gridDim.x * 8;
    const bf16_t* oraw = (const bf16_t*)(p.ws + WS_ORAW); const bf16_t* P1 = (const bf16_t*)(p.ws + WS_P1); bf16_t* og = (bf16_t*)(p.ws + WS_OG);
    for (int tok = gw; tok < T_TOK; tok += nw) {
        float o[32]; float ss = 0.f;
#pragma unroll
        for (int q = 0; q < 4; ++q) { const u32x4 a = *(const u32x4*)(oraw + (size_t)tok * 2048 + 32 * lane + 8 * q); const unsigned au[4] = {a.x, a.y, a.z, a.w};
#pragma unroll
            for (int i = 0; i < 4; ++i) { o[8 * q + 2 * i] = bflo(au[i]); o[8 * q + 2 * i + 1] = bfhi(au[i]); ss += o[8 * q + 2 * i] * o[8 * q + 2 * i] + o[8 * q + 2 * i + 1] * o[8 * q + 2 * i + 1]; } }
        ss = row16_sum(ss);
        const float rstd = rsqrtf(ss * (1.f / 512.f) + 1e-6f);
        const float* wn = p.onorm_b + 32 * lane;
#pragma unroll
        for (int q = 0; q < 4; ++q) { const u32x4 g = *(const u32x4*)(P1 + (size_t)tok * LDP1 + 4096 + 32 * lane + 8 * q); const unsigned gu[4] = {g.x, g.y, g.z, g.w}; unsigned r[4];
#pragma unroll
            for (int i = 0; i < 4; ++i) { const float v0 = o[8 * q + 2 * i] * rstd * wn[8 * q + 2 * i] * silu_f(bflo(gu[i])), v1 = o[8 * q + 2 * i + 1] * rstd * wn[8 * q + 2 * i + 1] * silu_f(bfhi(gu[i])); r[i] = pk_bf16(v0, v1); }
            *(u32x4*)(og + (size_t)tok * 2048 + 32 * lane + 8 * q) = (u32x4){r[0], r[1], r[2], r[3]}; }
    }
}

DI void phase_norm1(const Params& p) {
    const int lane = threadIdx.x & 63, gw = blockIdx.x * 8 + (threadIdx.x >> 6), nw = gridDim.x * 8;
    bf16_t* x1 = (bf16_t*)(p.ws + WS_X1); const float* part = (const float*)(p.ws + WS_PART1); bf16_t* out = (bf16_t*)(p.ws + WS_XN); const float* w = p.norm_w + 1024;
    for (int tok = gw; tok < T_TOK; tok += nw) {
        f32x4 v[4]; float ss = 0.f;
#pragma unroll
        for (int i = 0; i < 4; ++i) { const int c = 4 * lane + 256 * i;
            if (tok < T_PR) { const u32x2 t = *(const u32x2*)(x1 + (size_t)tok * 1024 + c); v[i] = (f32x4){bflo(t.x), bfhi(t.x), bflo(t.y), bfhi(t.y)}; }
            else { const size_t o = (size_t)(tok - T_PR) * 1024 + c; v[i] = *(const f32x4*)(p.xs + o);
#pragma unroll
                for (int s = 0; s < 4; ++s) v[i] += *(const f32x4*)(part + (size_t)s * 1048576 + o);
                u32x2 t; t.x = pk_bf16(v[i].x, v[i].y); t.y = pk_bf16(v[i].z, v[i].w); *(u32x2*)(x1 + (size_t)tok * 1024 + c) = t; }
            ss += v[i].x * v[i].x + v[i].y * v[i].y + v[i].z * v[i].z + v[i].w * v[i].w; }
        ss = wave_sum(ss);
        const float rstd = rsqrtf(ss * (1.f / 1024.f) + 1e-6f);
#pragma unroll
        for (int i = 0; i < 4; ++i) { const f32x4 ww = *(const f32x4*)(w + 4 * lane + 256 * i);
            u32x2 o; o.x = pk_bf16(v[i].x * rstd * ww.x, v[i].y * rstd * ww.y); o.y = pk_bf16(v[i].z * rstd * ww.z, v[i].w * rstd * ww.w);
            *(u32x2*)(out + (size_t)tok * 1024 + 4 * lane + 256 * i) = o; }
    }
}

DI void phase_final(const Params& p) {
    const int lane = threadIdx.x & 63, gw = blockIdx.x * 8 + (threadIdx.x >> 6), nw = gridDim.x * 8;
    const bf16_t* x2 = (const bf16_t*)(p.ws + WS_X2); const bf16_t* x1 = (const bf16_t*)(p.ws + WS_X1);
    for (int tok = gw; tok < T_TOK; tok += nw) {
        f32x4 v[4]; float ss = 0.f;
#pragma unroll
        for (int i = 0; i < 4; ++i) { const int c = 4 * lane + 256 * i;
            if (tok < T_PR) { const u32x2 t = *(const u32x2*)(x2 + (size_t)tok * 1024 + c); v[i] = (f32x4){bflo(t.x), bfhi(t.x), bflo(t.y), bfhi(t.y)}; }
            else { const size_t o = (size_t)(tok - T_PR) * 1024 + c; const u32x2 t = *(const u32x2*)(x1 + (size_t)tok * 1024 + c); v[i] = (f32x4){bflo(t.x), bfhi(t.x), bflo(t.y), bfhi(t.y)};
#pragma unroll
                for (int s = 0; s < 8; ++s) v[i] += *(const f32x4*)((const float*)(p.ws + WS_PART2) + (size_t)s * 1048576 + o); }
            ss += v[i].x * v[i].x + v[i].y * v[i].y + v[i].z * v[i].z + v[i].w * v[i].w; }
        ss = wave_sum(ss);
        const float rstd = rsqrtf(ss * (1.f / 1024.f) + 1e-6f);
#pragma unroll
        for (int i = 0; i < 4; ++i) { const f32x4 ww = *(const f32x4*)(p.fnorm_w + 4 * lane + 256 * i);
            *(f32x4*)(p.out + O_Y + (size_t)tok * 1024 + 4 * lane + 256 * i) = (f32x4){v[i].x * rstd * ww.x, v[i].y * rstd * ww.y, v[i].z * rstd * ww.z, v[i].w * rstd * ww.w}; }
    }
}

__global__ void __launch_bounds__(512) hybrid_fwd(Params p) {
    extern __shared__ __attribute__((aligned(16))) unsigned char smem[];
    cg::grid_group grid = cg::this_grid();
    volatile LAS unsigned* xst = (volatile LAS unsigned*)((LAS unsigned char*)smem + SMEM_XB);
    if (threadIdx.x < 4) xst[threadIdx.x] = 0u;
    __syncthreads();
    const XcdBarrier xb = xcd_barrier_post((unsigned*)(p.ws + WS_BAR), xst);
#ifdef ONLY_PH
#define RUN(k) ((k) == ONLY_PH)
#define SYNC(k)
#else
#define RUN(k) (p.ph_lo <= (k) && (k) < p.ph_hi)
#define SYNC(k) if (p.ph_lo < (k) && (k) < p.ph_hi) { if (p.use_cg) grid.sync(); else { xcd_barrier(xb); if ((PROBE_MASK >> 17) & 1) xcd_barrier(xb); } }
#endif
    _Pragma("unroll") for (int rep = 0; rep <= ((PROBE_MASK >> 0) & 1); ++rep) if (RUN(0)) phase_prep(p, smem);
    SYNC(1);
    _Pragma("unroll") for (int rep = 0; rep <= ((PROBE_MASK >> 1) & 1); ++rep) if (RUN(1)) { pg8::Gemm g{(const bf16_t*)(p.ws + WS_XN), (const bf16_t*)(p.ws + WS_WTA), T_TOK, LDP0, 1024, 1024}; pg8::StaticOrder S; S.init(g.M, g.N, gridDim.x, blockIdx.x);
                  pg8::EpiBf16 E{(bf16_t*)(p.ws + WS_P0), LDP0}; pg8::gemm_phase((LAS unsigned char*)smem, g, S, E); }
    SYNC(2);
    _Pragma("unroll") for (int rep = 0; rep <= ((PROBE_MASK >> 2) & 1); ++rep) if (RUN(2)) phase_gdn_prep(p, smem);
    SYNC(3);
    _Pragma("unroll") for (int rep = 0; rep <= ((PROBE_MASK >> 3) & 1); ++rep) if (RUN(3)) phase_gdn_scan(p, smem);
    SYNC(4);
    _Pragma("unroll") for (int rep = 0; rep <= ((PROBE_MASK >> 4) & 1); ++rep) if (RUN(4)) phase_gdn_gate(p);
    SYNC(5);
    _Pragma("unroll") for (int rep = 0; rep <= ((PROBE_MASK >> 5) & 1); ++rep) if (RUN(5)) { pg8::Gemm g{(const bf16_t*)(p.ws + WS_OG), (const bf16_t*)(p.ws + WS_WTOA), T_TOK, 1024, 1024, 1024}; pg8::MainOrder S{(int)gridDim.x, (int)blockIdx.x};
                  pg8::EpiResB<false> E{(bf16_t*)(p.ws + WS_X1), (const void*)p.xp}; pg8::gemm_phase((LAS unsigned char*)smem, g, S, E);
                  pg8::Gemm gt{g.A, g.Bt, T_TOK, 1024, 256, 1024}; pg8::TailOrder St{(int)gridDim.x, (int)blockIdx.x, 4, 256};
                  pg8::EpiPart Et{(float*)(p.ws + WS_PART1)}; pg8::gemm_phase((LAS unsigned char*)smem, gt, St, Et); }
    SYNC(6);
    _Pragma("unroll") for (int rep = 0; rep <= ((PROBE_MASK >> 6) & 1); ++rep) if (RUN(6)) phase_norm1(p);
    SYNC(7);
    _Pragma("unroll") for (int rep = 0; rep <= ((PROBE_MASK >> 7) & 1); ++rep) if (RUN(7)) { pg8::Gemm g{(const bf16_t*)(p.ws + WS_XN), (const bf16_t*)(p.ws + WS_WTB), T_TOK, LDP1, 1024, 1024}; pg8::StaticOrder S; S.init(g.M, g.N, gridDim.x, blockIdx.x);
                  pg8::EpiBf16 E{(bf16_t*)(p.ws + WS_P1), LDP1}; pg8::gemm_phase((LAS unsigned char*)smem, g, S, E); }
    SYNC(8);
    _Pragma("unroll") for (int rep = 0; rep <= ((PROBE_MASK >> 8) & 1); ++rep) if (RUN(8)) phase_ret_prep(p, smem);
    SYNC(9);
    _Pragma("unroll") for (int rep = 0; rep <= ((PROBE_MASK >> 9) & 1); ++rep) if (RUN(9)) phase_ret_scan(p, smem);
    SYNC(10);
    _Pragma("unroll") for (int rep = 0; rep <= ((PROBE_MASK >> 10) & 1); ++rep) if (RUN(10)) phase_ret_gate(p);
    SYNC(11);
    _Pragma("unroll") for (int rep = 0; rep <= ((PROBE_MASK >> 11) & 1); ++rep) if (RUN(11)) { pg8::Gemm g{(const bf16_t*)(p.ws + WS_OG), (const bf16_t*)(p.ws + WS_WTOB), T_TOK, 1024, 2048, 2048}; pg8::MainOrder S{(int)gridDim.x, (int)blockIdx.x};
                   pg8::EpiResB<true> E{(bf16_t*)(p.ws + WS_X2), (const void*)(p.ws + WS_X1)}; pg8::gemm_phase((LAS unsigned char*)smem, g, S, E);
                   pg8::Gemm gt{g.A, g.Bt, T_TOK, 1024, 256, 2048}; pg8::TailOrder St{(int)gridDim.x, (int)blockIdx.x, 8, 256};
                   pg8::EpiPart Et{(float*)(p.ws + WS_PART2)}; pg8::gemm_phase((LAS unsigned char*)smem, gt, St, Et); }
    SYNC(12);
    _Pragma("unroll") for (int rep = 0; rep <= ((PROBE_MASK >> 12) & 1); ++rep) if (RUN(12)) phase_final(p);
}

#ifndef N_LAUNCH_SPLIT
#define N_LAUNCH_SPLIT 0
#endif

extern "C" void kernel_launch(void* const* d_in, const int* in_sizes, int n_in, void* d_out, int out_size, void* d_ws, size_t ws_size, hipStream_t stream) {
    static int grid_blocks = 0;
    if (!grid_blocks) {
        hipFuncSetAttribute((const void*)hybrid_fwd, hipFuncAttributeMaxDynamicSharedMemorySize, (int)SMEM_BYTES);
        int dev = 0, cus = 0, per_cu = 0;
        hipGetDevice(&dev);
        hipDeviceGetAttribute(&cus, hipDeviceAttributeMultiprocessorCount, dev);
        hipOccupancyMaxActiveBlocksPerMultiprocessor(&per_cu, hybrid_fwd, 512, SMEM_BYTES);
        if (per_cu < 1) per_cu = 1;
        grid_blocks = cus * 1;
        if (grid_blocks < 72) { fprintf(stderr, "too few CUs: %d\n", grid_blocks); }
    }
    if (ws_size < WS_TOTAL) { fprintf(stderr, "workspace too small: %zu < %zu\n", ws_size, (size_t)WS_TOTAL); return; }
    hipMemsetAsync((unsigned char*)d_ws + WS_BAR, 0, 16384, stream);
    Params p{};
    p.xp = (const float*)d_in[0]; p.xs = (const float*)d_in[1]; p.st_gdn = (const float*)d_in[2]; p.st_conv = (const float*)d_in[3]; p.st_ret = (const float*)d_in[4];
    p.norm_w = (const float*)d_in[5]; p.w_in_a = (const float*)d_in[6]; p.conv_w = (const float*)d_in[7]; p.a_log = (const float*)d_in[8]; p.dt_bias = (const float*)d_in[9];
    p.onorm_a = (const float*)d_in[10]; p.w_out_a = (const float*)d_in[11]; p.w_in_b = (const float*)d_in[12]; p.onorm_b = (const float*)d_in[13]; p.w_out_b = (const float*)d_in[14];
    p.fnorm_w = (const float*)d_in[15];
    p.out = (float*)d_out; p.ws = (unsigned char*)d_ws;
#if N_LAUNCH_SPLIT
    for (int ph = 0; ph < NPH; ++ph) {
        p.ph_lo = ph; p.ph_hi = ph + 1;
        void* args[] = {&p};
        hipError_t e = hipLaunchCooperativeKernel((const void*)hybrid_fwd, dim3(grid_blocks), dim3(512), args, SMEM_BYTES, stream);
        if (e != hipSuccess) fprintf(stderr, "launch failed (phase %d): %s\n", ph, hipGetErrorString(e));
    }
#else
    p.ph_lo = 0; p.ph_hi = NPH;
    void* args[] = {&p};
    hipError_t e = hipLaunchCooperativeKernel((const void*)hybrid_fwd, dim3(grid_blocks), dim3(512), args, SMEM_BYTES, stream);
    if (e != hipSuccess) fprintf(stderr, "cooperative launch failed: %s (grid %d)\n", hipGetErrorString(e), grid_blocks);
#endif
}
```
